# Optimizing an MI355X kernel written in HIP

```python
import math
import jax, jax.numpy as jnp
from jax import lax
import numpy as np

D_MODEL = 1024
BATCH = 8
SEQ = 2048
DEPTH = 2

S5_WIDTH = D_MODEL // 2
S5_GROUP_CH = 16
S5_GROUPS = S5_WIDTH // S5_GROUP_CH
S5_STATE = 64
LRU_WIDTH = D_MODEL // 2
LRU_BLOCKS = 8
LRU_BLOCK_DIM = LRU_WIDTH // LRU_BLOCKS
CONV_WIDTH = 4
RG_C = 8.0
EVEN_IN = S5_WIDTH + 2 * LRU_WIDTH
EVEN_OUT = S5_WIDTH + LRU_WIDTH

MLA_HEADS = 8
Q_LORA = 384
KV_LORA = 256
NOPE_DIM = 128
ROPE_DIM = 64
V_DIM = 128
QK_DIM = NOPE_DIM + ROPE_DIM
MLA_IN = Q_LORA + KV_LORA + ROPE_DIM
ROPE_THETA = 10000.0
Q_BLOCK = 128

N_GROUPS = 8
EXPERTS_PER_GROUP = 8
N_EXPERTS = N_GROUPS * EXPERTS_PER_GROUP
TOP_K = 2
D_EXPERT = 256
MOE_BLOCK = 128

N_EVEN = (DEPTH + 1) // 2
N_ODD = DEPTH // 2
RMS_EPS = 1e-6
NEG_INF = -1e30

kernel_name = "hybrid_s5_rglru_mla_hmoe"


def rms_norm(x, g, eps=RMS_EPS):
    xf = x.astype(jnp.float32)
    y = xf * lax.rsqrt(jnp.mean(xf * xf, axis=-1, keepdims=True) + eps)
    return (y * g.astype(jnp.float32)).astype(x.dtype)


def linear_combine(e1, e2):
    a1, b1 = e1
    a2, b2 = e2
    return (a1 * a2, a2 * b1 + b2)


def complex_linear_combine(e1, e2):
    a1r, a1i, b1r, b1i = e1
    a2r, a2i, b2r, b2i = e2
    return (a2r * a1r - a2i * a1i,
            a2r * a1i + a2i * a1r,
            a2r * b1r - a2i * b1i + b2r,
            a2r * b1i + a2i * b1r + b2i)


def s5_mixer(u, lam_re, lam_im, log_dt, b_re, b_im, c_re, c_im, d, glu_w, glu_b):
    bsz, seq, _ = u.shape
    uf = u.astype(jnp.float32).reshape(bsz, seq, S5_GROUPS, S5_GROUP_CH)
    lr = jnp.minimum(lam_re.astype(jnp.float32), -1e-4)
    li = lam_im.astype(jnp.float32)
    dt = jnp.exp(log_dt.astype(jnp.float32))[:, None]
    mag = jnp.exp(lr * dt)
    lb_re = mag * jnp.cos(li * dt)
    lb_im = mag * jnp.sin(li * dt)
    den = lr * lr + li * li
    num_re = lb_re - 1.0
    f_re = (num_re * lr + lb_im * li) / den
    f_im = (lb_im * lr - num_re * li) / den
    br = b_re.astype(jnp.float32)
    bi = b_im.astype(jnp.float32)
    bbar_re = f_re[..., None] * br - f_im[..., None] * bi
    bbar_im = f_re[..., None] * bi + f_im[..., None] * br
    bu_re = jnp.einsum('blgh,gph->blgp', uf, bbar_re)
    bu_im = jnp.einsum('blgh,gph->blgp', uf, bbar_im)
    a_re = jnp.broadcast_to(lb_re, bu_re.shape)
    a_im = jnp.broadcast_to(lb_im, bu_im.shape)
    _, _, s_re, s_im = lax.associative_scan(
        complex_linear_combine, (a_re, a_im, bu_re, bu_im), axis=1)
    y = (jnp.einsum('blgp,ghp->blgh', s_re, c_re.astype(jnp.float32))
         - jnp.einsum('blgp,ghp->blgh', s_im, c_im.astype(jnp.float32))
         + d.astype(jnp.float32) * uf)
    y = jax.nn.gelu(y.reshape(bsz, seq, S5_WIDTH))
    return y * jax.nn.sigmoid(y @ glu_w.astype(jnp.float32) + glu_b.astype(jnp.float32))


def rglru_mixer(xb, gate_in, conv_w, conv_b, wa, ba, wi, bi, lam):
    bsz, seq, _ = xb.shape
    xc = lax.conv_general_dilated(
        xb, conv_w[:, None, :].astype(xb.dtype), window_strides=(1,),
        padding=[(CONV_WIDTH - 1, 0)], dimension_numbers=('NWC', 'WIO', 'NWC'),
        feature_group_count=LRU_WIDTH)
    xf = xc.astype(jnp.float32) + conv_b.astype(jnp.float32)
    xr = xf.reshape(bsz, seq, LRU_BLOCKS, LRU_BLOCK_DIM)
    r = jax.nn.sigmoid(jnp.einsum('blnc,ncd->blnd', xr, wa.astype(jnp.float32))
                       .reshape(bsz, seq, LRU_WIDTH) + ba.astype(jnp.float32))
    i = jax.nn.sigmoid(jnp.einsum('blnc,ncd->blnd', xr, wi.astype(jnp.float32))
                       .reshape(bsz, seq, LRU_WIDTH) + bi.astype(jnp.float32))
    log_a = RG_C * r * jax.nn.log_sigmoid(lam.astype(jnp.float32))
    a = jnp.exp(log_a)
    b = jnp.sqrt(-jnp.expm1(2.0 * log_a)) * (i * xf)
    _, h = lax.associative_scan(linear_combine, (a, b), axis=1)
    return h * jax.nn.gelu(gate_in.astype(jnp.float32))


def even_mixer(h, w_in, lam_re, lam_im, log_dt, b_re, b_im, c_re, c_im, d, glu_w, glu_b,
               conv_w, conv_b, wa, ba, wi, bi, lam, w_out):
    proj = h @ w_in
    u_s5 = proj[..., :S5_WIDTH]
    x_lru = proj[..., S5_WIDTH:S5_WIDTH + LRU_WIDTH]
    g_lru = proj[..., S5_WIDTH + LRU_WIDTH:]
    ya = s5_mixer(u_s5, lam_re, lam_im, log_dt, b_re, b_im, c_re, c_im, d, glu_w, glu_b)
    yb = rglru_mixer(x_lru, g_lru, conv_w, conv_b, wa, ba, wi, bi, lam)
    y = jnp.concatenate([ya, yb], axis=-1).astype(h.dtype)
    return y @ w_out


def apply_rope(t, cos, sin):
    half = ROPE_DIM // 2
    t1, t2 = t[..., :half], t[..., half:]
    c = cos[:, :, None, :]
    s = sin[:, :, None, :]
    return jnp.concatenate([t1 * c - t2 * s, t1 * s + t2 * c], axis=-1)


def causal_block_attention(q, k, v):
    bsz, seq, nh, dh = q.shape
    dv = v.shape[-1]
    nb = seq // Q_BLOCK
    qb = q.transpose(0, 2, 1, 3).reshape(bsz, nh, nb, Q_BLOCK, dh).transpose(2, 0, 1, 3, 4)
    kt = k.transpose(0, 2, 1, 3)
    vt = v.transpose(0, 2, 1, 3)
    key_pos = jnp.arange(seq)
    scale = 1.0 / math.sqrt(dh)

    def one_block(args):
        q_blk, blk = args
        s = jnp.einsum('bhqd,bhkd->bhqk', q_blk, kt) * scale
        q_pos = blk * Q_BLOCK + jnp.arange(Q_BLOCK)
        s = jnp.where(key_pos[None, :] <= q_pos[:, None], s, NEG_INF)
        p = jax.nn.softmax(s, axis=-1)
        return jnp.einsum('bhqk,bhkd->bhqd', p, vt)

    o = lax.map(one_block, (qb, jnp.arange(nb)))
    return o.transpose(1, 0, 3, 2, 4).reshape(bsz, seq, nh * dv)


def mla_mixer(h, positions, w_in, cq_norm, ckv_norm, w_uq, w_ukv, q_norm, k_norm, w_o):
    bsz, seq, _ = h.shape
    proj = h @ w_in
    c_q = rms_norm(proj[..., :Q_LORA], cq_norm)
    c_kv = rms_norm(proj[..., Q_LORA:Q_LORA + KV_LORA], ckv_norm)
    k_rope = proj[..., Q_LORA + KV_LORA:]
    q = (c_q @ w_uq).reshape(bsz, seq, MLA_HEADS, QK_DIM)
    kv = (c_kv @ w_ukv).reshape(bsz, seq, MLA_HEADS, NOPE_DIM + V_DIM)
    k_nope, v = kv[..., :NOPE_DIM], kv[..., NOPE_DIM:]
    k = jnp.concatenate(
        [k_nope, jnp.broadcast_to(k_rope[:, :, None, :], (bsz, seq, MLA_HEADS, ROPE_DIM))], axis=-1)
    q = rms_norm(q, q_norm).astype(jnp.float32)
    k = rms_norm(k, k_norm).astype(jnp.float32)
    inv_freq = 1.0 / (ROPE_THETA ** (jnp.arange(0, ROPE_DIM, 2, dtype=jnp.float32) / ROPE_DIM))
    ang = positions.astype(jnp.float32)[..., None] * inv_freq
    cos, sin = jnp.cos(ang), jnp.sin(ang)
    q = jnp.concatenate([q[..., :NOPE_DIM], apply_rope(q[..., NOPE_DIM:], cos, sin)], axis=-1)
    k = jnp.concatenate([k[..., :NOPE_DIM], apply_rope(k[..., NOPE_DIM:], cos, sin)], axis=-1)
    o = causal_block_attention(q, k, v.astype(jnp.float32))
    return o.astype(h.dtype) @ w_o


def hierarchical_moe(h, w_group, b_group, w_expert, b_expert, w1, w3, w2):
    bsz, seq, dm = h.shape
    n_tok = bsz * seq
    hf = h.reshape(n_tok, dm)
    g_logits = (hf @ w_group).astype(jnp.float32) + b_group.astype(jnp.float32)
    g_prob = jax.nn.softmax(g_logits, axis=-1)
    g_sel = jnp.argmax(g_logits, axis=-1)
    p_g = jnp.take_along_axis(g_prob, g_sel[:, None], axis=1)[:, 0]
    e_logits = ((hf @ w_expert).astype(jnp.float32) + b_expert.astype(jnp.float32)
                ).reshape(n_tok, N_GROUPS, EXPERTS_PER_GROUP)
    e_in_group = jnp.take_along_axis(e_logits, g_sel[:, None, None], axis=1)[:, 0]
    top_vals, top_idx = lax.top_k(e_in_group, TOP_K)
    gates = p_g[:, None] * jax.nn.softmax(top_vals, axis=-1)
    expert_id = g_sel[:, None].astype(jnp.int32) * EXPERTS_PER_GROUP + top_idx.astype(jnp.int32)
    n_assign = n_tok * TOP_K
    e_flat = expert_id.reshape(-1)
    tok_flat = jnp.arange(n_assign, dtype=jnp.int32) // TOP_K
    g_flat = gates.reshape(-1)
    order = jnp.argsort(e_flat)
    e_sorted = e_flat[order]
    tok_sorted = tok_flat[order]
    g_sorted = g_flat[order]
    counts = jnp.bincount(e_flat, length=N_EXPERTS).astype(jnp.int32)
    starts = jnp.cumsum(counts) - counts
    padded = ((counts + MOE_BLOCK - 1) // MOE_BLOCK) * MOE_BLOCK
    pad_ends = jnp.cumsum(padded)
    pad_starts = pad_ends - padded
    dest = pad_starts[e_sorted] + (jnp.arange(n_assign, dtype=jnp.int32) - starts[e_sorted])
    n_blocks = -(-n_assign // MOE_BLOCK) + N_EXPERTS
    n_rows = n_blocks * MOE_BLOCK
    x_disp = jnp.zeros((n_rows, dm), h.dtype).at[dest].set(hf[tok_sorted])
    blk_start = jnp.arange(n_blocks, dtype=jnp.int32) * MOE_BLOCK
    blk_expert = jnp.clip(jnp.searchsorted(pad_ends, blk_start, side='right'), 0, N_EXPERTS - 1)

    def expert_block(args):
        xb, e = args
        return (jax.nn.silu(xb @ w1[e]) * (xb @ w3[e])) @ w2[e]

    y_disp = lax.map(expert_block, (x_disp.reshape(n_blocks, MOE_BLOCK, dm), blk_expert))
    y_disp = y_disp.reshape(n_rows, dm)
    out = jnp.zeros((n_tok, dm), h.dtype).at[tok_sorted].add(
        g_sorted[:, None].astype(h.dtype) * y_disp[dest])
    return out.reshape(bsz, seq, dm)


def setup_inputs(seed: int = 0) -> dict:
    key = jax.random.key(seed)
    keys = iter(jax.random.split(key, 64))

    def nrm(shape, scale):
        return jax.random.normal(next(keys), shape, jnp.float32) * scale

    def gain(shape):
        return 1.0 + nrm(shape, 0.01)

    x = jax.random.normal(next(keys), (BATCH, SEQ, D_MODEL), jnp.float32)
    offset = jax.random.randint(next(keys), (BATCH, 1), 0, 4096, dtype=jnp.int32)
    positions = offset + jnp.arange(SEQ, dtype=jnp.int32)[None, :]

    n_idx = jnp.arange(S5_STATE, dtype=jnp.float32)
    lam_im0 = jnp.broadcast_to(jnp.pi * n_idx, (N_EVEN, S5_GROUPS, S5_STATE))
    u_lru = jax.random.uniform(next(keys), (N_EVEN, LRU_WIDTH), jnp.float32, 0.9, 0.999)

    return {
        'x': x,
        'positions': positions,
        'ev_norm': gain((N_EVEN, D_MODEL)),
        'ev_w_in': nrm((N_EVEN, D_MODEL, EVEN_IN), D_MODEL ** -0.5),
        's5_lambda_re': -0.5 + nrm((N_EVEN, S5_GROUPS, S5_STATE), 0.01),
        's5_lambda_im': lam_im0 + nrm((N_EVEN, S5_GROUPS, S5_STATE), 0.01),
        's5_log_dt': jax.random.uniform(next(keys), (N_EVEN, S5_GROUPS), jnp.float32,
                                        math.log(1e-3), math.log(1e-1)),
        's5_b_re': nrm((N_EVEN, S5_GROUPS, S5_STATE, S5_GROUP_CH), (2 * S5_GROUP_CH) ** -0.5),
        's5_b_im': nrm((N_EVEN, S5_GROUPS, S5_STATE, S5_GROUP_CH), (2 * S5_GROUP_CH) ** -0.5),
        's5_c_re': nrm((N_EVEN, S5_GROUPS, S5_GROUP_CH, S5_STATE), S5_STATE ** -0.5),
        's5_c_im': nrm((N_EVEN, S5_GROUPS, S5_GROUP_CH, S5_STATE), S5_STATE ** -0.5),
        's5_d': nrm((N_EVEN, S5_GROUPS, S5_GROUP_CH), 1.0),
        's5_glu_w': nrm((N_EVEN, S5_WIDTH, S5_WIDTH), S5_WIDTH ** -0.5),
        's5_glu_b': nrm((N_EVEN, S5_WIDTH), 0.01),
        'lru_conv_w': nrm((N_EVEN, CONV_WIDTH, LRU_WIDTH), CONV_WIDTH ** -0.5),
        'lru_conv_b': nrm((N_EVEN, LRU_WIDTH), 0.01),
        'lru_wa': nrm((N_EVEN, LRU_BLOCKS, LRU_BLOCK_DIM, LRU_BLOCK_DIM), LRU_BLOCK_DIM ** -0.5),
        'lru_ba': nrm((N_EVEN, LRU_WIDTH), 0.01),
        'lru_wi': nrm((N_EVEN, LRU_BLOCKS, LRU_BLOCK_DIM, LRU_BLOCK_DIM), LRU_BLOCK_DIM ** -0.5),
        'lru_bi': nrm((N_EVEN, LRU_WIDTH), 0.01),
        'lru_lambda': jnp.log(u_lru) - jnp.log1p(-u_lru),
        'ev_w_out': nrm((N_EVEN, EVEN_OUT, D_MODEL), EVEN_OUT ** -0.5),
        'od_norm': gain((N_ODD, D_MODEL)),
        'mla_w_in': nrm((N_ODD, D_MODEL, MLA_IN), D_MODEL ** -0.5),
        'mla_cq_norm': gain((N_ODD, Q_LORA)),
        'mla_ckv_norm': gain((N_ODD, KV_LORA)),
        'mla_w_uq': nrm((N_ODD, Q_LORA, MLA_HEADS * QK_DIM), Q_LORA ** -0.5),
        'mla_w_ukv': nrm((N_ODD, KV_LORA, MLA_HEADS * (NOPE_DIM + V_DIM)), KV_LORA ** -0.5),
        'mla_q_norm': gain((N_ODD, QK_DIM)),
        'mla_k_norm': gain((N_ODD, QK_DIM)),
        'mla_w_o': nrm((N_ODD, MLA_HEADS * V_DIM, D_MODEL), (MLA_HEADS * V_DIM) ** -0.5),
        'ffn_norm': gain((DEPTH, D_MODEL)),
        'moe_w_group': nrm((DEPTH, D_MODEL, N_GROUPS), D_MODEL ** -0.5),
        'moe_b_group': nrm((DEPTH, N_GROUPS), 0.01),
        'moe_w_expert': nrm((DEPTH, D_MODEL, N_EXPERTS), D_MODEL ** -0.5),
        'moe_b_expert': nrm((DEPTH, N_EXPERTS), 0.01),
        'moe_w1': nrm((DEPTH, N_EXPERTS, D_MODEL, D_EXPERT), D_MODEL ** -0.5),
        'moe_w3': nrm((DEPTH, N_EXPERTS, D_MODEL, D_EXPERT), D_MODEL ** -0.5),
        'moe_w2': nrm((DEPTH, N_EXPERTS, D_EXPERT, D_MODEL), D_EXPERT ** -0.5),
    }


def reference(x, positions, ev_norm, ev_w_in, s5_lambda_re, s5_lambda_im, s5_log_dt,
              s5_b_re, s5_b_im, s5_c_re, s5_c_im, s5_d, s5_glu_w, s5_glu_b,
              lru_conv_w, lru_conv_b, lru_wa, lru_ba, lru_wi, lru_bi, lru_lambda, ev_w_out,
              od_norm, mla_w_in, mla_cq_norm, mla_ckv_norm, mla_w_uq, mla_w_ukv,
              mla_q_norm, mla_k_norm, mla_w_o,
              ffn_norm, moe_w_group, moe_b_group, moe_w_expert, moe_b_expert,
              moe_w1, moe_w3, moe_w2):
    for layer in range(DEPTH):
        j = layer // 2
        if layer % 2 == 0:
            x = x + even_mixer(
                rms_norm(x, ev_norm[j]), ev_w_in[j], s5_lambda_re[j], s5_lambda_im[j],
                s5_log_dt[j], s5_b_re[j], s5_b_im[j], s5_c_re[j], s5_c_im[j], s5_d[j],
                s5_glu_w[j], s5_glu_b[j], lru_conv_w[j], lru_conv_b[j], lru_wa[j], lru_ba[j],
                lru_wi[j], lru_bi[j], lru_lambda[j], ev_w_out[j])
        else:
            x = x + mla_mixer(
                rms_norm(x, od_norm[j]), positions, mla_w_in[j], mla_cq_norm[j],
                mla_ckv_norm[j], mla_w_uq[j], mla_w_ukv[j], mla_q_norm[j], mla_k_norm[j],
                mla_w_o[j])
        x = x + hierarchical_moe(
            rms_norm(x, ffn_norm[layer]), moe_w_group[layer], moe_b_group[layer],
            moe_w_expert[layer], moe_b_expert[layer], moe_w1[layer], moe_w3[layer],
            moe_w2[layer])
    return x
```

```cpp
#include <hip/hip_runtime.h>
#include <cstdio>
#include <cstdint>
namespace pg8 {
#define PG8_LAS __attribute__((address_space(3)))
typedef unsigned short bf16_t;
typedef short bf16x8 __attribute__((ext_vector_type(8)));
typedef float f32x4 __attribute__((ext_vector_type(4)));
typedef unsigned u32x4 __attribute__((ext_vector_type(4)));
constexpr int BM = 256, BK = 64, HALF = 128, HTB = HALF * BK * 2  , STAGE_BYTES = 8 * HTB, NXCD = 8, WGM = 8;

__host__ __device__ __forceinline__ int lds_byte(int r, int c) { const int st = (r >> 4) * 2 + (c >> 5), rr = r & 15, cc = c & 31, ob = rr * 64 + cc * 2; return st * 1024 + (ob ^ (((ob >> 9) & 1) << 5)); }
__host__ __device__ __forceinline__ void stage_rc(int b, int& R, int& C) { const int st = b / 1024, sb = b % 1024, swz = sb ^ (((sb >> 9) & 1) << 5); R = (st >> 1) * 16 + swz / 64; C = (st & 1) * 32 + (swz % 64) / 2; }
__host__ __device__ __forceinline__ int perm32(int rho) { const int n = rho >> 4, i = rho & 15; return 8 * (i >> 2) + 4 * n + (i & 3); }

struct Unit { int pm, pn; };
struct Gemm { const bf16_t* A; const bf16_t* Bt; int M, N, K; };

struct StaticOrder {
    int nM, nN, nwg, G, c;
    __host__ __device__ void init(int M, int N, int G_, int c_) { nM = M / BM; nN = N / BM; nwg = nM * nN; G = G_; c = c_; }
    __host__ __device__ bool next(int i, Unit& u) const {
        const long L = (long)i * G + c; if (L >= nwg) return false;
        int wgid = (int)L; { const int q = nwg / NXCD, r = nwg % NXCD, xcd = wgid % NXCD, off = wgid / NXCD; wgid = (xcd < r ? xcd * (q + 1) : r * (q + 1) + (xcd - r) * q) + off; }
        const int nig = WGM * nN, gid = wgid / nig, fm = gid * WGM, gsz = (nM - fm) < WGM ? (nM - fm) : WGM;
        u.pm = fm + ((wgid % nig) % gsz); u.pn = (wgid % nig) / gsz; return true;
    }
    __device__ __forceinline__ void a_ready(const Unit&) const {}
    __device__ __forceinline__ void done(const Unit&) const {}
};
struct CountedOrder : StaticOrder {
    const unsigned* ready; unsigned need; unsigned* tmo;
    __device__ __forceinline__ void a_ready(const Unit& u) const {
        if (threadIdx.x < 64) {
            const unsigned long long t0 = __builtin_amdgcn_s_memrealtime(); unsigned polls = 0;
            while ((unsigned)__builtin_amdgcn_readfirstlane(__hip_atomic_load(ready + 64 * u.pm, __ATOMIC_RELAXED, __HIP_MEMORY_SCOPE_AGENT)) < need) {
                if ((++polls & 255u) == 0u && __builtin_amdgcn_readfirstlane(__hip_atomic_load(tmo, __ATOMIC_RELAXED, __HIP_MEMORY_SCOPE_AGENT)) != 0u) break;
                if (__builtin_amdgcn_s_memrealtime() - t0 > 2000000ull) {
                    if (threadIdx.x == 0) { unsigned expect = 0u; __hip_atomic_compare_exchange_strong(tmo + 1, &expect, 0x600u | (unsigned)(u.pm & 0xff), __ATOMIC_RELAXED, __ATOMIC_RELAXED, __HIP_MEMORY_SCOPE_AGENT); __hip_atomic_store(tmo, 1u, __ATOMIC_RELAXED, __HIP_MEMORY_SCOPE_AGENT); }
                    break; }
                __builtin_amdgcn_s_sleep(2); }
            __builtin_amdgcn_fence(__ATOMIC_ACQUIRE, "agent");
            asm volatile("s_waitcnt vmcnt(0)" ::: "memory");
        }
#if !defined(BROKEN_HOOK_NO_BARRIER)
        asm volatile("" ::: "memory"); __builtin_amdgcn_s_barrier(); asm volatile("" ::: "memory");
#endif
    }
};

__device__ __forceinline__ unsigned cvt_pk_bf16(float lo, float hi) { unsigned r; asm volatile("v_cvt_pk_bf16_f32 %0, %1, %2" : "=v"(r) : "v"(lo), "v"(hi)); return r; }
typedef float f32x2 __attribute__((ext_vector_type(2)));
__device__ __forceinline__ f32x2 gelu_pk(f32x2 v) {
    const f32x2 av = __builtin_elementwise_abs(v), d = av * 0.2316418882f + 1.0f;
    f32x2 t; t.x = __builtin_amdgcn_rcpf(d.x); t.y = __builtin_amdgcn_rcpf(d.y);
    f32x2 q = t * 0.5307027145f + (-0.7265760135f); q = q * t + 0.7107068705f; q = q * t + (-0.142248368f); q = q * t + 0.127414796f; q = q * t;
    const f32x2 s = (v * v) * (-0.72134752044f);
    f32x2 e; e.x = __builtin_amdgcn_exp2f(s.x); e.y = __builtin_amdgcn_exp2f(s.y);
    const f32x2 m = v * (q * e), r = v - m;
    f32x2 o; o.x = v.x < 0.f ? m.x : r.x; o.y = v.y < 0.f ? m.y : r.y; return o;
}

struct EpiF32 {
    static constexpr bool PERM = false, AFTER_DRAIN = false;
    float* C; int ldc; const float* bias;
    __device__ __forceinline__ void operator()(const f32x4 (&acc)[2][2][4][2], const Unit& u, int wr, int wc, int fr, int fq) const {
        const int row0 = u.pm * BM + wr * 64 + fr, col0 = u.pn * BM + wc * 32 + 4 * fq;
        f32x4 bv[2][2];
#pragma unroll
        for (int bj = 0; bj < 2; ++bj)
#pragma unroll
            for (int n = 0; n < 2; ++n) bv[bj][n] = bias ? *(const f32x4*)(bias + col0 + bj * HALF + n * 16) : (f32x4){0.f, 0.f, 0.f, 0.f};
#pragma unroll
        for (int ai = 0; ai < 2; ++ai)
#pragma unroll
            for (int m = 0; m < 4; ++m) { float* rowp = C + (size_t)(row0 + ai * HALF + m * 16) * ldc + col0;
#pragma unroll
                for (int bj = 0; bj < 2; ++bj)
#pragma unroll
                    for (int n = 0; n < 2; ++n) *(f32x4*)(rowp + bj * HALF + n * 16) = acc[ai][bj][m][n] + bv[bj][n]; }
    }
};
template <int ACT  > struct EpiBf16 {
    static constexpr bool PERM = true, AFTER_DRAIN = false;
    bf16_t* O; int ldc; const float* bias; int split_cols; size_t split_stride;
    __device__ __forceinline__ void operator()(const f32x4 (&acc)[2][2][4][2], const Unit& u, int wr, int wc, int fr, int fq) const {
        const int row0 = u.pm * BM + wr * 64 + fr; int colt = u.pn * BM; bf16_t* base = O;
        if (split_cols) { const int t = colt / split_cols; base += (size_t)t * split_stride; colt -= t * split_cols; }
        const int col0 = colt + wc * 32 + 8 * fq, bcol0 = u.pn * BM + wc * 32 + 8 * fq;
        f32x4 bv[2][2];
#pragma unroll
        for (int bj = 0; bj < 2; ++bj)
#pragma unroll
            for (int n = 0; n < 2; ++n) bv[bj][n] = bias ? *(const f32x4*)(bias + bcol0 + bj * HALF + 4 * n) : (f32x4){0.f, 0.f, 0.f, 0.f};
#pragma unroll
        for (int ai = 0; ai < 2; ++ai)
#pragma unroll
            for (int m = 0; m < 4; ++m) { bf16_t* rowp = base + (size_t)(row0 + ai * HALF + m * 16) * ldc + col0;
#pragma unroll
                for (int bj = 0; bj < 2; ++bj) { f32x4 v0 = acc[ai][bj][m][0] + bv[bj][0], v1 = acc[ai][bj][m][1] + bv[bj][1];
                    if (ACT == 1) { f32x2 a = gelu_pk((f32x2){v0[0], v0[1]}), b = gelu_pk((f32x2){v0[2], v0[3]}), c = gelu_pk((f32x2){v1[0], v1[1]}), d = gelu_pk((f32x2){v1[2], v1[3]});
                        v0 = (f32x4){a.x, a.y, b.x, b.y}; v1 = (f32x4){c.x, c.y, d.x, d.y}; }
                    if (ACT == 2) {
#pragma unroll
                        for (int j = 0; j < 4; ++j) { v0[j] = 0.5f * v0[j] * (1.0f + erff(v0[j] * 0.70710678f)); v1[j] = 0.5f * v1[j] * (1.0f + erff(v1[j] * 0.70710678f)); } }
                    u32x4 w; w.x = cvt_pk_bf16(v0[0], v0[1]); w.y = cvt_pk_bf16(v0[2], v0[3]); w.z = cvt_pk_bf16(v1[0], v1[1]); w.w = cvt_pk_bf16(v1[2], v1[3]);
                    *(u32x4*)(rowp + bj * HALF) = w; } }
    }
};
__device__ __forceinline__ float bf2f(unsigned b16) { return __uint_as_float(b16 << 16); }
__device__ __forceinline__ float bflo(unsigned w) { return __uint_as_float(w << 16); }
__device__ __forceinline__ float bfhi(unsigned w) { return __uint_as_float(w & 0xffff0000u); }
__device__ __forceinline__ float sigm(float x) { return 1.0f / (1.0f + __expf(-x)); }

struct EpiResF32 {
    static constexpr bool PERM = false, AFTER_DRAIN = false;
    const float* res; float* out; int ldc;
    __device__ __forceinline__ void operator()(const f32x4 (&acc)[2][2][4][2], const Unit& u, int wr, int wc, int fr, int fq) const {
        const int row0 = u.pm * BM + wr * 64 + fr, col0 = u.pn * BM + wc * 32 + 4 * fq;
#pragma unroll
        for (int ai = 0; ai < 2; ++ai)
#pragma unroll
            for (int m = 0; m < 4; ++m) { const size_t off = (size_t)(row0 + ai * HALF + m * 16) * ldc + col0;
#pragma unroll
                for (int bj = 0; bj < 2; ++bj)
#pragma unroll
                    for (int n = 0; n < 2; ++n) { const f32x4 r = *(const f32x4*)(res + off + bj * HALF + n * 16); *(f32x4*)(out + off + bj * HALF + n * 16) = acc[ai][bj][m][n] + r; } }
    }
};
struct EpiBf16N {
    static constexpr bool PERM = true, AFTER_DRAIN = false;
    bf16_t* O; int ldc; int nct;
    __device__ __forceinline__ void operator()(const f32x4 (&acc)[2][2][4][2], const Unit& u, int wr, int wc, int fr, int fq) const {
        const int row0 = u.pm * BM + wr * 64 + fr, col0 = (u.pn % nct) * BM + wc * 32 + 8 * fq;
#pragma unroll
        for (int ai = 0; ai < 2; ++ai)
#pragma unroll
            for (int m = 0; m < 4; ++m) { bf16_t* rowp = O + (size_t)(row0 + ai * HALF + m * 16) * ldc + col0;
#pragma unroll
                for (int bj = 0; bj < 2; ++bj) { const f32x4 v0 = acc[ai][bj][m][0], v1 = acc[ai][bj][m][1];
                    u32x4 w; w.x = cvt_pk_bf16(v0[0], v0[1]); w.y = cvt_pk_bf16(v0[2], v0[3]); w.z = cvt_pk_bf16(v1[0], v1[1]); w.w = cvt_pk_bf16(v1[2], v1[3]);
                    *(u32x4*)(rowp + bj * HALF) = w; } }
    }
};
struct EpiGlu {
    static constexpr bool PERM = true, AFTER_DRAIN = false;
    const bf16_t* Y; int ldy; bf16_t* O; int ldo; const float* bias;
    __device__ __forceinline__ void operator()(const f32x4 (&acc)[2][2][4][2], const Unit& u, int wr, int wc, int fr, int fq) const {
        const int row0 = u.pm * BM + wr * 64 + fr, col0 = u.pn * BM + wc * 32 + 8 * fq;
        f32x4 bv[2][2];
#pragma unroll
        for (int bj = 0; bj < 2; ++bj)
#pragma unroll
            for (int n = 0; n < 2; ++n) bv[bj][n] = *(const f32x4*)(bias + col0 + bj * HALF + 4 * n);
#pragma unroll
        for (int ai = 0; ai < 2; ++ai)
#pragma unroll
            for (int m = 0; m < 4; ++m) { const int r = row0 + ai * HALF + m * 16;
#pragma unroll
                for (int bj = 0; bj < 2; ++bj) { const int c = col0 + bj * HALF;
                    const u32x4 yv = *(const u32x4*)(Y + (size_t)r * ldy + c);
                    const f32x4 v0 = acc[ai][bj][m][0] + bv[bj][0], v1 = acc[ai][bj][m][1] + bv[bj][1];
                    u32x4 w;
                    w.x = cvt_pk_bf16(bflo(yv.x) * sigm(v0[0]), bfhi(yv.x) * sigm(v0[1]));
                    w.y = cvt_pk_bf16(bflo(yv.y) * sigm(v0[2]), bfhi(yv.y) * sigm(v0[3]));
                    w.z = cvt_pk_bf16(bflo(yv.z) * sigm(v1[0]), bfhi(yv.z) * sigm(v1[1]));
                    w.w = cvt_pk_bf16(bflo(yv.w) * sigm(v1[2]), bfhi(yv.w) * sigm(v1[3]));
                    *(u32x4*)(O + (size_t)r * ldo + c) = w; } }
    }
};
struct EpiSwiGlu {
    static constexpr bool PERM = true, AFTER_DRAIN = false;
    bf16_t* H;
    __device__ __forceinline__ void operator()(const f32x4 (&acc)[2][2][4][2], const Unit& u, int wr, int wc, int fr, int fq) const {
        const int row0 = u.pm * BM + wr * 64 + fr, col0 = (u.pn & 1) * HALF + wc * 32 + 8 * fq;
#pragma unroll
        for (int ai = 0; ai < 2; ++ai)
#pragma unroll
            for (int m = 0; m < 4; ++m) { const int r = row0 + ai * HALF + m * 16;
                float o[8];
#pragma unroll
                for (int n = 0; n < 2; ++n)
#pragma unroll
                    for (int i = 0; i < 4; ++i) { const float a1 = acc[ai][0][m][n][i], a3 = acc[ai][1][m][n][i]; o[4 * n + i] = a1 * sigm(a1) * a3; }
                u32x4 w; w.x = cvt_pk_bf16(o[0], o[1]); w.y = cvt_pk_bf16(o[2], o[3]); w.z = cvt_pk_bf16(o[4], o[5]); w.w = cvt_pk_bf16(o[6], o[7]);
                *(u32x4*)(H + (size_t)r * 256 + col0) = w; }
    }
};
struct EpiMlaIn {
    static constexpr bool PERM = true, AFTER_DRAIN = false;
    bf16_t* CQ; bf16_t* CKV; bf16_t* KR;
    __device__ __forceinline__ void operator()(const f32x4 (&acc)[2][2][4][2], const Unit& u, int wr, int wc, int fr, int fq) const {
        const int row0 = u.pm * BM + wr * 64 + fr, col0 = u.pn * BM + wc * 32 + 8 * fq;
#pragma unroll
        for (int ai = 0; ai < 2; ++ai)
#pragma unroll
            for (int m = 0; m < 4; ++m) { const int r = row0 + ai * HALF + m * 16;
#pragma unroll
                for (int bj = 0; bj < 2; ++bj) { const int c = col0 + bj * HALF; const f32x4 v0 = acc[ai][bj][m][0], v1 = acc[ai][bj][m][1];
                    u32x4 w; w.x = cvt_pk_bf16(v0[0], v0[1]); w.y = cvt_pk_bf16(v0[2], v0[3]); w.z = cvt_pk_bf16(v1[0], v1[1]); w.w = cvt_pk_bf16(v1[2], v1[3]);
                    if (c < 384) *(u32x4*)(CQ + (size_t)r * 384 + c) = w;
                    else if (c < 640) *(u32x4*)(CKV + (size_t)r * 256 + (c - 384)) = w;
                    else if (c < 704) *(u32x4*)(KR + (size_t)r * 64 + (c - 640)) = w; } }
    }
};
struct GroupedOrder {
    const PG8_LAS int* tile_e; int n_rt, nct, G, c;
    __device__ __forceinline__ bool next(int i, Unit& u) const {
        const int L = i * G + c; if (L >= n_rt * nct) return false;
        const int rt = L / nct, j = L - rt * nct; u.pm = rt; u.pn = tile_e[rt] * nct + j; return true; }
    __device__ __forceinline__ void a_ready(const Unit&) const {}
    __device__ __forceinline__ void done(const Unit&) const {}
};
template <class Epi, class Sched, bool STAMP = false>
__device__ __forceinline__ void gemm_phase(PG8_LAS unsigned char* lds, const Gemm g, const Sched& S, const Epi& E, unsigned long long* stamps) {
    int tid_ = threadIdx.x; asm volatile("" : "+v"(tid_));
    const int tid = tid_, wid = __builtin_amdgcn_readfirstlane(tid >> 6), lane = tid & 63, wr = wid >> 2, wc = wid & 3, fr = lane & 15, fq = lane >> 4;
    const int K = g.K, nt = K / BK;
    int ts_lo = 0, ts_hi = 0, nts = 0; const unsigned long long rt_entry = STAMP ? (unsigned long long)wall_clock64() : 0ull;
#define PG8_STAMP() do { if (STAMP && wid == 0 && nts < 64) { const unsigned long long _c = (unsigned long long)clock64(); \
        ts_lo = (lane == nts) ? (int)(unsigned)_c : ts_lo; ts_hi = (lane == nts) ? (int)(unsigned)(_c >> 32) : ts_hi; ++nts; } } while (0)
    PG8_STAMP();
    unsigned voffA[2], voffB[2];
#pragma unroll
    for (int i = 0; i < 2; ++i) { int R, C; stage_rc(tid * 16 + i * 8192, R, C); const int Rb = Epi::PERM ? ((R & ~31) + perm32(R & 31)) : R;
        voffA[i] = (unsigned)(R * K + C) * 2u; voffB[i] = (unsigned)(Rb * K + C) * 2u; }
    const size_t kstep = (size_t)(BK * 2);
    const size_t hstep = (size_t)HALF * K * 2;
    const size_t tstep = 2 * hstep;
    const unsigned ldsw = (unsigned)wid * 1024u;
    const int aoff = lds_byte(wr * 64 + fr, fq * 8), boff = lds_byte(wc * 32 + fr, fq * 8);
#define PG8_SA(b, h) (((b) * 2 + (h)) * HTB)
#define PG8_SB(b, h) ((4 + (b) * 2 + (h)) * HTB)
#define PG8_STAGE(bufoff, gbase, voff) do { _Pragma("unroll") for (int _i = 0; _i < 2; ++_i) \
        __builtin_amdgcn_global_load_lds((const unsigned*)((const char*)(gbase) + (voff)[_i]), (PG8_LAS unsigned*)(lds + (bufoff) + ldsw + _i * 8192), 16, 0, 0); } while (0)
#define PG8_LDA(dst, b, h) do { _Pragma("unroll") for (int m = 0; m < 4; ++m) _Pragma("unroll") for (int k = 0; k < 2; ++k) dst[m][k] = *(const PG8_LAS bf16x8*)(lds + PG8_SA(b, h) + aoff + m * 2048 + k * 1024); } while (0)
#define PG8_LDB(dst, b, h) do { _Pragma("unroll") for (int n = 0; n < 2; ++n) _Pragma("unroll") for (int k = 0; k < 2; ++k) dst[n][k] = *(const PG8_LAS bf16x8*)(lds + PG8_SB(b, h) + boff + n * 2048 + k * 1024); } while (0)
#define PG8_MMA(ai, bj, At, Bt) do { __builtin_amdgcn_s_setprio(1); _Pragma("unroll") for (int m = 0; m < 4; ++m) _Pragma("unroll") for (int n = 0; n < 2; ++n) _Pragma("unroll") for (int k = 0; k < 2; ++k) \
        acc[ai][bj][m][n] = __builtin_amdgcn_mfma_f32_16x16x32_bf16(Bt[n][k], At[m][k], acc[ai][bj][m][n], 0, 0, 0); __builtin_amdgcn_s_setprio(0); } while (0)
#define PG8_WAIT_V(n) asm volatile("s_waitcnt vmcnt(" #n ")" ::: "memory")
#define PG8_WAIT_L(n) asm volatile("s_waitcnt lgkmcnt(" #n ")" ::: "memory")
#define PG8_BAR __builtin_amdgcn_s_barrier()
#define PG8_SCHED __builtin_amdgcn_sched_barrier(0)
    Unit cur, nxt; int ui = 0;
    if (!S.next(0, cur)) return;
    f32x4 acc[2][2][4][2];
#pragma unroll
    for (int a = 0; a < 2; ++a)
#pragma unroll
        for (int b = 0; b < 2; ++b)
#pragma unroll
            for (int m = 0; m < 4; ++m)
#pragma unroll
                for (int n = 0; n < 2; ++n) acc[a][b][m][n] = (f32x4){0.f, 0.f, 0.f, 0.f};
    bf16x8 At[4][2], B0[2][2], B1[2][2];
    const char* cA = (const char*)g.A + (size_t)cur.pm * tstep; const char* cB = (const char*)g.Bt + (size_t)cur.pn * tstep;
    S.a_ready(cur);
    PG8_STAGE(PG8_SB(0, 0), cB, voffB); PG8_STAGE(PG8_SA(0, 0), cA, voffA); PG8_STAGE(PG8_SB(0, 1), cB + hstep, voffB); PG8_STAGE(PG8_SA(0, 1), cA + hstep, voffA);
    if (wr == 1) PG8_BAR;
    PG8_WAIT_V(4); PG8_BAR;
    PG8_STAGE(PG8_SB(1, 0), cB + kstep, voffB); PG8_STAGE(PG8_SA(1, 0), cA + kstep, voffA); PG8_STAGE(PG8_SB(1, 1), cB + hstep + kstep, voffB);
    PG8_WAIT_V(6); PG8_BAR;
    PG8_STAMP();
    for (;;) {
        const bool has_next = S.next(ui + 1, nxt);
        const char* nA = has_next ? (const char*)g.A + (size_t)nxt.pm * tstep : cA; const char* nB = has_next ? (const char*)g.Bt + (size_t)nxt.pn * tstep : cB;
        for (int t = 0; t < nt; t += 2) {
            const bool last = (t == nt - 2);
            const char* a1 = cA + (size_t)(t + 1) * kstep;
            const char* a2 = last ? nA : cA + (size_t)(t + 2) * kstep; const char* b2 = last ? nB : cB + (size_t)(t + 2) * kstep;
            const char* a3 = a2 + kstep; const char* b3 = b2 + kstep;
            if (last && has_next) S.a_ready(nxt);
            PG8_LDB(B0, 0, 0); PG8_SCHED; PG8_LDA(At, 0, 0); PG8_STAGE(PG8_SA(1, 1), a1 + hstep, voffA);
            PG8_WAIT_L(8); PG8_BAR; PG8_WAIT_L(0); PG8_MMA(0, 0, At, B0); PG8_BAR; PG8_SCHED;
            PG8_LDB(B1, 0, 1); PG8_STAGE(PG8_SB(0, 0), b2, voffB);
            PG8_BAR; PG8_WAIT_L(0); PG8_MMA(0, 1, At, B1); PG8_BAR;
            PG8_LDA(At, 0, 1); PG8_STAGE(PG8_SA(0, 0), a2, voffA);
            PG8_BAR; PG8_WAIT_L(0); PG8_MMA(1, 0, At, B0); PG8_BAR; PG8_SCHED;
            PG8_STAGE(PG8_SB(0, 1), b2 + hstep, voffB);
            PG8_WAIT_V(6); PG8_BAR; PG8_MMA(1, 1, At, B1); PG8_BAR;
            PG8_LDB(B0, 1, 0); PG8_SCHED; PG8_LDA(At, 1, 0); PG8_STAGE(PG8_SA(0, 1), a2 + hstep, voffA);
            PG8_WAIT_L(8); PG8_BAR; PG8_WAIT_L(0); PG8_MMA(0, 0, At, B0); PG8_BAR; PG8_SCHED;
            PG8_LDB(B1, 1, 1); PG8_STAGE(PG8_SB(1, 0), b3, voffB);
            PG8_BAR; PG8_WAIT_L(0); PG8_MMA(0, 1, At, B1); PG8_BAR;
            PG8_LDA(At, 1, 1); PG8_STAGE(PG8_SA(1, 0), a3, voffA);
            PG8_BAR; PG8_WAIT_L(0); PG8_MMA(1, 0, At, B0); PG8_BAR; PG8_SCHED;
            PG8_STAGE(PG8_SB(1, 1), b3 + hstep, voffB);
            PG8_WAIT_V(6); PG8_BAR; PG8_MMA(1, 1, At, B1); PG8_BAR;
        }
        PG8_STAMP();
        if constexpr (!Epi::AFTER_DRAIN) { E(acc, cur, wr, wc, fr, fq); S.done(cur); }
        PG8_STAMP();
        if (!has_next) break;
#pragma unroll
        for (int a = 0; a < 2; ++a)
#pragma unroll
            for (int b = 0; b < 2; ++b)
#pragma unroll
                for (int m = 0; m < 4; ++m)
#pragma unroll
                    for (int n = 0; n < 2; ++n) acc[a][b][m][n] = (f32x4){0.f, 0.f, 0.f, 0.f};
        cur = nxt; cA = nA; cB = nB; ++ui;
    }
    PG8_WAIT_V(0);
    if (wr == 0) PG8_BAR;
    PG8_BAR;
    if constexpr (Epi::AFTER_DRAIN) { E.fused(acc, cur, wr, wc, fr, fq, lds, wid, lane); S.done(cur); }
    PG8_STAMP();
    if (STAMP && wid == 0) { stamps[lane] = lane < nts ? (((unsigned long long)(unsigned)ts_hi << 32) | (unsigned)ts_lo) : 0ull;
        if (lane == 62) stamps[62] = rt_entry; if (lane == 63) stamps[63] = (unsigned long long)wall_clock64(); }
#undef PG8_STAMP
#undef PG8_SA
#undef PG8_SB
#undef PG8_STAGE
#undef PG8_LDA
#undef PG8_LDB
#undef PG8_MMA
#undef PG8_WAIT_V
#undef PG8_WAIT_L
#undef PG8_BAR
#undef PG8_SCHED
}
}
#ifndef STOP_AFTER
#define STOP_AFTER 99
#endif
#ifndef PH_MASK
#define PH_MASK 0xffffffffu
#endif
#define PH(k) ((PH_MASK >> (k)) & 1u)
constexpr int NT = 16384, DM = 1024, NB = 8, SL = 2048;
constexpr int NWAVES = 8;
constexpr float RMS_EPS = 1e-6f;
constexpr size_t MiB = 1u << 20;
constexpr size_t WS_CTL = 0, CTL_ZERO_BYTES = 1 * MiB;
constexpr size_t WS_WIN = 1 * MiB;
constexpr size_t WS_GLU = 4 * MiB;
constexpr size_t WS_WOUT = WS_GLU + MiB / 2;
constexpr size_t WS_MIN = WS_WOUT + 2 * MiB;
constexpr size_t WS_UQ = 8 * MiB;
constexpr size_t WS_UK = WS_UQ + 5 * MiB / 4;
constexpr size_t WS_UV = WS_UK + MiB / 2;
constexpr size_t WS_WO = WS_UV + MiB / 2;
constexpr size_t WS_WR = WS_WO + 2 * MiB;
constexpr size_t WS_W13 = 13 * MiB;
constexpr size_t WS_W2 = 77 * MiB;
constexpr size_t WS_X2 = 109 * MiB;
constexpr size_t WS_XN = 173 * MiB;
constexpr size_t WS_AR = 205 * MiB;
constexpr size_t WS_END = WS_AR + 254 * MiB;
static_assert(WS_WR + 2 * 96 * 1024 * 2 <= WS_W13, "ws map");
constexpr size_t AR_PROJ = WS_AR, AR_YAPRE = WS_AR + 48 * MiB, AR_YCAT = WS_AR + 64 * MiB;
constexpr size_t AR_XDISP = WS_AR, AR_H = WS_AR + 96 * MiB, AR_YDISP = WS_AR + 120 * MiB, AR_TOK = WS_AR + 216 * MiB;
constexpr int MAX_RT = 192;
constexpr size_t AR_CQR = WS_AR, AR_CKVR = WS_AR + 12 * MiB, AR_KRR = WS_AR + 20 * MiB, AR_COS = WS_AR + 22 * MiB, AR_SIN = WS_AR + 24 * MiB,
                 AR_CQ = WS_AR + 26 * MiB, AR_CKV = WS_AR + 38 * MiB, AR_QRAW = WS_AR + 46 * MiB, AR_KNRAW = WS_AR + 94 * MiB, AR_VT = WS_AR + 126 * MiB,
                 AR_QF = WS_AR + 158 * MiB, AR_KF = WS_AR + 206 * MiB, AR_O = AR_QRAW;
constexpr int CW_BAR = 4096, CW_CNT = 8192;
constexpr int RING_BYTES = 131072;
constexpr int WSCR = 17408;
constexpr int EX_OFF = 8 * WSCR;
constexpr int TAB_OFF = EX_OFF + 4096;
constexpr int MISC_OFF = TAB_OFF + 1280;
constexpr int LDS_BYTES = 147456;
static_assert(MISC_OFF + 128 <= LDS_BYTES, "LDS map");

#define GAS __attribute__((address_space(1)))
#define LAS __attribute__((address_space(3)))
typedef unsigned short bf16;
typedef unsigned v4u __attribute__((ext_vector_type(4)));
typedef unsigned v2u __attribute__((ext_vector_type(2)));
typedef float f32x4 __attribute__((ext_vector_type(4)));
typedef float f32x16 __attribute__((ext_vector_type(16)));
typedef short bf16x8 __attribute__((ext_vector_type(8)));
typedef GAS unsigned gu32;
#define RLX_AGENT __ATOMIC_RELAXED, __HIP_MEMORY_SCOPE_AGENT
#define LDS_WAIT() asm volatile("s_waitcnt lgkmcnt(0)" ::: "memory")
#define VM_WAIT() asm volatile("s_waitcnt vmcnt(0)" ::: "memory")
#define CBAR() asm volatile("" ::: "memory")
__device__ __forceinline__ unsigned f2bf(float f) { unsigned u = __builtin_bit_cast(unsigned, f); return (u + 0x7fffu + ((u >> 16) & 1u)) >> 16; }
__device__ __forceinline__ unsigned pk2(float lo, float hi) { return f2bf(lo) | (f2bf(hi) << 16); }
__device__ __forceinline__ float bf2f(unsigned b16) { return __uint_as_float(b16 << 16); }
__device__ __forceinline__ float bflo(unsigned w) { return __uint_as_float(w << 16); }
__device__ __forceinline__ float bfhi(unsigned w) { return __uint_as_float(w & 0xffff0000u); }
__device__ __forceinline__ float sigm(float x) { return 1.0f / (1.0f + __expf(-x)); }
__device__ __forceinline__ float gelu_tanh(float x) { const float z = 0.7978845608028654f * (x + 0.044715f * x * x * x); const float t = 1.0f - 2.0f / (1.0f + __expf(2.0f * z)); return 0.5f * x * (1.0f + t); }
__device__ __forceinline__ float wave_sum(float v) {
#pragma unroll
    for (int o = 1; o < 64; o <<= 1) v += __shfl_xor(v, o);
    return v;
}
__device__ __forceinline__ int crow(int r, int hi) { return (r & 3) + 8 * (r >> 2) + 4 * hi; }

#define XB_TMO      128
#define XB_XCNT(j)  (256  + 64 * (j))
#define XB_XSUB(j)  (1280 + 64 * (j))
#define XB_XGEN(j)  (2304 + 64 * (j))
#define XB_TOP      3328
#define XB_TOPGEN   3392
#define XCD_BAR_WORDS 3456
#define XB_SPIN_CAP (1u << 18)
__device__ __forceinline__ unsigned xb_ld(unsigned* p)              { return __hip_atomic_load(p, __ATOMIC_RELAXED, __HIP_MEMORY_SCOPE_AGENT); }
__device__ __forceinline__ unsigned xb_add(unsigned* p, unsigned v) { return __hip_atomic_fetch_add(p, v, __ATOMIC_RELAXED, __HIP_MEMORY_SCOPE_AGENT); }
__device__ __forceinline__ unsigned xb_xcc_id() { return (unsigned)__builtin_amdgcn_s_getreg((3 << 11) | 20) & 0xFu; }
#define XB_SPIN(cond, bar) do { unsigned _sp = 0; while (cond) { __builtin_amdgcn_s_sleep(1); \
    if ((++_sp & 255u) == 0u) { if (xb_ld(&(bar)[XB_TMO])) break; if (_sp > XB_SPIN_CAP) { atomicAdd(&(bar)[XB_TMO], 1u); break; } } } } while (0)
struct XcdBarrier { unsigned* bar; unsigned x; volatile LAS unsigned* st; };
__device__ __forceinline__ XcdBarrier xcd_barrier_post(unsigned* bar, volatile LAS unsigned* st) {
    XcdBarrier b; b.bar = bar; b.x = xb_xcc_id(); b.st = st;
    if (threadIdx.x == 0) (void)xb_add(&bar[XB_XCNT(b.x)], 1u);
    return b;
}
__device__ __forceinline__ void xcd_barrier_complete(unsigned* bar, unsigned x, unsigned& nloc, unsigned& nx) {
    const unsigned G = gridDim.x * gridDim.y * gridDim.z;
    unsigned sum, cnt, mine, sp = 0u;
    for (;;) {
        sum = 0u; cnt = 0u; mine = 0u;
#pragma unroll
        for (unsigned j = 0; j < 16; ++j) { const unsigned c = xb_ld(&bar[XB_XCNT(j)]); sum += c; cnt += (c > 0u) ? 1u : 0u; mine = (j == x) ? c : mine; }
        if (sum == G) break;
        __builtin_amdgcn_s_sleep(1);
        if ((++sp & 255u) == 0u) { if (xb_ld(&bar[XB_TMO])) break; if (sp > XB_SPIN_CAP) { atomicAdd(&bar[XB_TMO], 1u); break; } }
    }
    nloc = mine > 0u ? mine : 1u; nx = cnt > 0u ? cnt : 1u;
}
__device__ __forceinline__ void xcd_barrier(const XcdBarrier& b) {
    asm volatile("s_waitcnt vmcnt(0)" ::: "memory");
    __syncthreads();
    if (threadIdx.x == 0) {
        unsigned* bar = b.bar;
        __builtin_amdgcn_s_waitcnt(0);
        unsigned nloc = b.st[0], nx = b.st[1];
        if (nloc == 0u) { xcd_barrier_complete(bar, b.x, nloc, nx); b.st[0] = nloc; b.st[1] = nx; }
        const unsigned old = xb_add(&bar[XB_XSUB(b.x)], 1u);
        const unsigned gen = old / nloc;
        if (old + 1u == (gen + 1u) * nloc) {
            __builtin_amdgcn_fence(__ATOMIC_RELEASE, "agent");
            asm volatile("s_waitcnt vmcnt(0)" ::: "memory");
            const unsigned og = xb_add(&bar[XB_TOP], 1u);
            const unsigned tg = og / nx;
            if (og + 1u == (tg + 1u) * nx) xb_add(&bar[XB_TOPGEN], 1u);
            else XB_SPIN(xb_ld(&bar[XB_TOPGEN]) == tg, bar);
            __builtin_amdgcn_fence(__ATOMIC_ACQUIRE, "agent");
            xb_add(&bar[XB_XGEN(b.x)], 1u);
            asm volatile("s_waitcnt vmcnt(0)" ::: "memory");
        } else {
            XB_SPIN(xb_ld(&bar[XB_XGEN(b.x)]) == gen, bar);
            __builtin_amdgcn_fence(__ATOMIC_ACQUIRE, "agent");
            asm volatile("s_waitcnt vmcnt(0)" ::: "memory");
        }
    }
    __syncthreads();
}

struct Args { const float* in[39]; const int* pos; float* out; unsigned char* ws; };
struct Frame {
    LAS unsigned char* lds;
    int tid, lane, wave, vcu, G, gw, ngw;
};

__device__ __forceinline__ void tr_item(const float* W, int N, int k0, int n0, bf16* dst, int ldk, LAS float* scr, int lane) {
#pragma unroll 8
    for (int i = 0; i < 32; ++i) { const int kk = 2 * i + (lane >> 5); scr[kk * 33 + (lane & 31)] = W[(size_t)(k0 + kk) * N + n0 + (lane & 31)]; }
    LDS_WAIT(); CBAR();
    const int c = lane & 7;
#pragma unroll
    for (int j = 0; j < 4; ++j) { const int n = (lane >> 3) + 8 * j; const LAS float* s = scr + (8 * c) * 33 + n;
        v4u o; o.x = pk2(s[0 * 33], s[1 * 33]); o.y = pk2(s[2 * 33], s[3 * 33]); o.z = pk2(s[4 * 33], s[5 * 33]); o.w = pk2(s[6 * 33], s[7 * 33]);
        *(v4u*)(dst + (size_t)n * ldk + k0 + 8 * c) = o; }
    LDS_WAIT(); CBAR();
}
__device__ __forceinline__ void tr_plain(const float* W, int K, int N, bf16* WT, int item, LAS float* scr, int lane) {
    const int nblk = N / 32, kb = item / nblk, nb = item % nblk;
    tr_item(W, N, 64 * kb, 32 * nb, WT + (size_t)(32 * nb) * K, K, scr, lane);
}
__device__ __forceinline__ void conv_moe(const Frame& F, const Args& a, int layer, LAS float* scr) {
    bf16* W13T = (bf16*)(a.ws + WS_W13); bf16* W2T = (bf16*)(a.ws + WS_W2);
    for (int it = F.gw; it < 3 * 8192; it += F.ngw) {
        const int type = it >> 13, r = it & 8191, e = r >> 7, q = r & 127;
        if (type < 2) {
            const float* W = a.in[type == 0 ? 36 : 37] + (size_t)(layer * 64 + e) * 1024 * 256;
            const int kb = q >> 3, nb = q & 7, n0 = 32 * nb;
            const int drow = e * 512 + (n0 >> 7) * 256 + (type == 1 ? 128 : 0) + (n0 & 127);
            tr_item(W, 256, 64 * kb, n0, W13T + (size_t)drow * 1024, 1024, scr, F.lane);
        } else {
            const float* W = a.in[38] + (size_t)(layer * 64 + e) * 256 * 1024;
            const int kb = q >> 5, nb = q & 31, n0 = 32 * nb;
            tr_item(W, 1024, 64 * kb, n0, W2T + (size_t)(e * 1024 + n0) * 256, 256, scr, F.lane);
        }
    }
}
__device__ __forceinline__ void norm_row(const f32x4 (&v)[4], const f32x4 (&g)[4], bf16* orow, int lane) {
    float s = 0.f;
#pragma unroll
    for (int j = 0; j < 4; ++j) s += (v[j].x * v[j].x + v[j].y * v[j].y) + (v[j].z * v[j].z + v[j].w * v[j].w);
    const float rs = rsqrtf(wave_sum(s) * (1.f / DM) + RMS_EPS);
    v2u* o8 = (v2u*)orow + lane;
#pragma unroll
    for (int j = 0; j < 4; ++j) { v2u w; w.x = pk2(v[j].x * rs * g[j].x, v[j].y * rs * g[j].y); w.y = pk2(v[j].z * rs * g[j].z, v[j].w * rs * g[j].w); o8[64 * j] = w; }
}

__device__ __forceinline__ void p0_prologue(const Frame& F, const Args& a) {
    LAS float* scr = (LAS float*)(F.lds + F.wave * WSCR);
    unsigned char* ws = a.ws;
    for (int it = F.gw; it < 2816; it += F.ngw) {
        int r = it;
        if (r < 768) { tr_plain(a.in[3], 1024, 1536, (bf16*)(ws + WS_WIN), r, scr, F.lane); continue; } r -= 768;
        if (r < 128) { tr_plain(a.in[12], 512, 512, (bf16*)(ws + WS_GLU), r, scr, F.lane); continue; } r -= 128;
        if (r < 512) { tr_plain(a.in[21], 1024, 1024, (bf16*)(ws + WS_WOUT), r, scr, F.lane); continue; } r -= 512;
        if (r < 352) { tr_plain(a.in[23], 1024, 704, (bf16*)(ws + WS_MIN), r, scr, F.lane); continue; } r -= 352;
        if (r < 288) { tr_plain(a.in[26], 384, 1536, (bf16*)(ws + WS_UQ), r, scr, F.lane); continue; } r -= 288;
        if (r < 256) {
            const int kb = r / 64, nb = r % 64, n0 = 32 * nb, h = n0 >> 8, rr = n0 & 255;
            bf16* dst = (rr < 128) ? (bf16*)(ws + WS_UK) + (size_t)(h * 128 + rr) * 256 : (bf16*)(ws + WS_UV) + (size_t)(h * 128 + rr - 128) * 256;
            tr_item(a.in[27], 2048, 64 * kb, n0, dst, 256, scr, F.lane); continue; } r -= 256;
        tr_plain(a.in[30], 1024, 1024, (bf16*)(ws + WS_WO), r, scr, F.lane);
    }
    { v4u* z = (v4u*)((bf16*)(ws + WS_MIN) + (size_t)704 * 1024); const int n16 = 64 * 1024 * 2 / 16;
      for (int i = F.gw * 64 + F.lane; i < n16; i += F.ngw * 64) z[i] = (v4u){0u, 0u, 0u, 0u}; }
    { bf16* wr = (bf16*)(ws + WS_WR);
      for (int i = F.gw * 64 + F.lane; i < 2 * 96 * 1024; i += F.ngw * 64) {
          const int layer = i / (96 * 1024), rem = i % (96 * 1024), r = rem >> 10, k = rem & 1023;
          float v = 0.f;
          if (r < 8) v = a.in[32][(size_t)(layer * 1024 + k) * 8 + r];
          else if (r < 72) v = a.in[34][(size_t)(layer * 1024 + k) * 64 + (r - 8)];
          wr[i] = (bf16)f2bf(v); } }
    conv_moe(F, a, 0, scr);
    { const float* x = a.in[0]; const float* gn = a.in[2]; bf16* XN = (bf16*)(ws + WS_XN);
      f32x4 g[4];
#pragma unroll
      for (int j = 0; j < 4; ++j) g[j] = *((const f32x4*)gn + F.lane + 64 * j);
      for (int m = F.gw; m < NT; m += F.ngw) { f32x4 v[4]; const f32x4* xr = (const f32x4*)(x + (size_t)m * DM) + F.lane;
#pragma unroll
          for (int j = 0; j < 4; ++j) v[j] = xr[64 * j];
          norm_row(v, g, XN + (size_t)m * DM, F.lane); } }
}

__device__ __forceinline__ void cmul_acc(float& sr, float& si, float ar, float ai, float br, float bi) { const float nr = ar * sr - ai * si + br, ni = ar * si + ai * sr + bi; sr = nr; si = ni; }
__device__ __forceinline__ void s5_unit(const Frame& F, const Args& a, int b, int g) {
    const int lane = F.lane, w = F.wave, r32 = lane & 31, hh = lane >> 5;
    LAS float* BU = (LAS float*)(F.lds + w * WSCR);
    LAS float* EX = (LAS float*)(F.lds + EX_OFF);
    const bf16* PROJ = (const bf16*)(a.ws + AR_PROJ); bf16* YAPRE = (bf16*)(a.ws + AR_YAPRE);
    const float* lam_re = a.in[4] + g * 64; const float* lam_im = a.in[5] + g * 64; const float dt = __expf(a.in[6][g]);
    const float* b_re = a.in[7] + (size_t)g * 64 * 16; const float* b_im = a.in[8] + (size_t)g * 64 * 16;
    const float* c_re = a.in[9] + (size_t)g * 16 * 64; const float* c_im = a.in[10] + (size_t)g * 16 * 64; const float* dvec = a.in[11] + g * 16;
    float lbr, lbi;
    { const float lr = fminf(lam_re[lane], -1e-4f), li = lam_im[lane]; const float mag = expf(lr * dt); lbr = mag * cosf(li * dt); lbi = mag * sinf(li * dt); }
    bf16x8 af[4];
#pragma unroll
    for (int pb = 0; pb < 2; ++pb) {
        const int p = r32 + 32 * pb;
        const float lr = fminf(lam_re[p], -1e-4f), li = lam_im[p]; const float mag = expf(lr * dt); const float pr = mag * cosf(li * dt), pi = mag * sinf(li * dt);
        const float den = lr * lr + li * li, nr = pr - 1.0f; const float fr_ = (nr * lr + pi * li) / den, fi_ = (pi * lr - nr * li) / den;
        const f32x4 br0 = *(const f32x4*)(b_re + p * 16 + 8 * hh), br1 = *(const f32x4*)(b_re + p * 16 + 8 * hh + 4);
        const f32x4 bi0 = *(const f32x4*)(b_im + p * 16 + 8 * hh), bi1 = *(const f32x4*)(b_im + p * 16 + 8 * hh + 4);
        v4u wre, wim;
        wre.x = pk2(fr_ * br0.x - fi_ * bi0.x, fr_ * br0.y - fi_ * bi0.y); wre.y = pk2(fr_ * br0.z - fi_ * bi0.z, fr_ * br0.w - fi_ * bi0.w);
        wre.z = pk2(fr_ * br1.x - fi_ * bi1.x, fr_ * br1.y - fi_ * bi1.y); wre.w = pk2(fr_ * br1.z - fi_ * bi1.z, fr_ * br1.w - fi_ * bi1.w);
        wim.x = pk2(fr_ * bi0.x + fi_ * br0.x, fr_ * bi0.y + fi_ * br0.y); wim.y = pk2(fr_ * bi0.z + fi_ * br0.z, fr_ * bi0.w + fi_ * br0.w);
        wim.z = pk2(fr_ * bi1.x + fi_ * br1.x, fr_ * bi1.y + fi_ * br1.y); wim.w = pk2(fr_ * bi1.z + fi_ * br1.z, fr_ * bi1.w + fi_ * br1.w);
        af[pb] = __builtin_bit_cast(bf16x8, wre); af[2 + pb] = __builtin_bit_cast(bf16x8, wim);
    }
    const int h16 = lane & 15, kq = lane >> 4;
    bf16x8 cf[4];
#pragma unroll
    for (int ks = 0; ks < 4; ++ks) {
        const int k = 32 * ks + 8 * kq; const float* src = (k < 64) ? (c_re + h16 * 64 + k) : (c_im + h16 * 64 + (k - 64)); const float sg = (k < 64) ? 1.f : -1.f;
        const f32x4 c0 = *(const f32x4*)src, c1 = *(const f32x4*)(src + 4);
        v4u wv; wv.x = pk2(sg * c0.x, sg * c0.y); wv.y = pk2(sg * c0.z, sg * c0.w); wv.z = pk2(sg * c1.x, sg * c1.y); wv.w = pk2(sg * c1.z, sg * c1.w);
        cf[ks] = __builtin_bit_cast(bf16x8, wv);
    }
    const f32x4 dv = *(const f32x4*)(dvec + 4 * kq);
    const size_t tbase = (size_t)b * SL + (size_t)w * 256;
    float sr = 0.f, si = 0.f;
    for (int pass = 0; pass < 2; ++pass) {
        if (pass == 1) {
            EX[w * 128 + lane] = sr; EX[w * 128 + 64 + lane] = si;
            LDS_WAIT(); __syncthreads();
            float pr = lbr, pi = lbi;
#pragma unroll
            for (int q = 0; q < 8; ++q) { const float nr = pr * pr - pi * pi, ni = 2.f * pr * pi; pr = nr; pi = ni; }
            sr = 0.f; si = 0.f;
            for (int wp = 0; wp < w; ++wp) cmul_acc(sr, si, pr, pi, EX[wp * 128 + lane], EX[wp * 128 + 64 + lane]);
        }
        for (int sb = 0; sb < 8; ++sb) {
            const size_t t0 = tbase + sb * 32;
            const bf16x8 uf = *(const bf16x8*)(PROJ + (t0 + r32) * 1536 + g * 16 + 8 * hh);
            CBAR();
#pragma unroll
            for (int blk = 0; blk < 4; ++blk) {
                f32x16 acc = {};
                acc = __builtin_amdgcn_mfma_f32_32x32x16_bf16(af[blk], uf, acc, 0, 0, 0);
#pragma unroll
                for (int q = 0; q < 4; ++q) *(LAS f32x4*)(BU + r32 * 132 + 32 * blk + 8 * q + 4 * hh) = (f32x4){acc[4 * q], acc[4 * q + 1], acc[4 * q + 2], acc[4 * q + 3]};
            }
            LDS_WAIT(); CBAR();
            if (pass == 0) {
#pragma unroll 8
                for (int t = 0; t < 32; ++t) cmul_acc(sr, si, lbr, lbi, BU[t * 132 + lane], BU[t * 132 + 64 + lane]);
            } else {
#pragma unroll 8
                for (int t = 0; t < 32; ++t) { cmul_acc(sr, si, lbr, lbi, BU[t * 132 + lane], BU[t * 132 + 64 + lane]); BU[t * 132 + lane] = sr; BU[t * 132 + 64 + lane] = si; }
                LDS_WAIT(); CBAR();
#pragma unroll
                for (int tb = 0; tb < 2; ++tb) {
                    f32x4 y = {0.f, 0.f, 0.f, 0.f};
#pragma unroll
                    for (int ks = 0; ks < 4; ++ks) {
                        const LAS float* sp = BU + (16 * tb + h16) * 132 + 32 * ks + 8 * kq;
                        const f32x4 s0 = *(const LAS f32x4*)sp, s1 = *(const LAS f32x4*)(sp + 4);
                        v4u wv; wv.x = pk2(s0.x, s0.y); wv.y = pk2(s0.z, s0.w); wv.z = pk2(s1.x, s1.y); wv.w = pk2(s1.z, s1.w);
                        y = __builtin_amdgcn_mfma_f32_16x16x32_bf16(cf[ks], __builtin_bit_cast(bf16x8, wv), y, 0, 0, 0);
                    }
                    const size_t t = t0 + 16 * tb + h16;
                    const v2u uu = *(const v2u*)(PROJ + t * 1536 + g * 16 + 4 * kq);
                    const float y0 = gelu_tanh(y[0] + dv.x * bflo(uu.x)), y1 = gelu_tanh(y[1] + dv.y * bfhi(uu.x)), y2 = gelu_tanh(y[2] + dv.z * bflo(uu.y)), y3 = gelu_tanh(y[3] + dv.w * bfhi(uu.y));
                    v2u o; o.x = pk2(y0, y1); o.y = pk2(y2, y3);
                    *(v2u*)(YAPRE + t * 512 + g * 16 + 4 * kq) = o;
                }
                LDS_WAIT(); CBAR();
            }
        }
    }
    __syncthreads();
}
__device__ __forceinline__ void lru_unit(const Frame& F, const Args& a, int b, int n) {
    const int lane = F.lane, w = F.wave, r32 = lane & 31, hh = lane >> 5, ch = n * 64 + lane;
    LAS unsigned char* scrb = F.lds + w * WSCR;
    LAS bf16* XF = (LAS bf16*)scrb;
    LAS float* GA = (LAS float*)scrb;
    LAS float* GI = (LAS float*)(scrb + 32 * 68 * 4);
    LAS float* EX = (LAS float*)(F.lds + EX_OFF);
    const bf16* PROJ = (const bf16*)(a.ws + AR_PROJ); bf16* YCAT = (bf16*)(a.ws + AR_YCAT);
    const float cw0 = a.in[14][0 * 512 + ch], cw1 = a.in[14][1 * 512 + ch], cw2 = a.in[14][2 * 512 + ch], cw3 = a.in[14][3 * 512 + ch], cb = a.in[15][ch];
    const float ba = a.in[17][ch], bi = a.in[19][ch];
    const float lsl8 = -8.0f * log1pf(expf(-a.in[20][ch]));
    bf16x8 fa[2][4], fi[2][4];
    { const float* wa = a.in[16] + (size_t)n * 64 * 64; const float* wi = a.in[18] + (size_t)n * 64 * 64;
#pragma unroll
      for (int blk = 0; blk < 2; ++blk)
#pragma unroll
          for (int s = 0; s < 4; ++s) { const int d = r32 + 32 * blk, c0 = 16 * s + 8 * hh; float va[8], vi[8];
#pragma unroll
              for (int j = 0; j < 8; ++j) { va[j] = wa[(c0 + j) * 64 + d]; vi[j] = wi[(c0 + j) * 64 + d]; }
              v4u x; x.x = pk2(va[0], va[1]); x.y = pk2(va[2], va[3]); x.z = pk2(va[4], va[5]); x.w = pk2(va[6], va[7]); fa[blk][s] = __builtin_bit_cast(bf16x8, x);
              v4u y; y.x = pk2(vi[0], vi[1]); y.y = pk2(vi[2], vi[3]); y.z = pk2(vi[4], vi[5]); y.w = pk2(vi[6], vi[7]); fi[blk][s] = __builtin_bit_cast(bf16x8, y); } }
    const int l0 = w * 256; const size_t tbase = (size_t)b * SL + l0;
    float hst = 0.f, aprod = 1.f;
    for (int pass = 0; pass < 2; ++pass) {
        if (pass == 1) {
            EX[w * 64 + lane] = aprod; EX[512 + w * 64 + lane] = hst;
            LDS_WAIT(); __syncthreads();
            hst = 0.f;
            for (int wp = 0; wp < w; ++wp) hst = EX[wp * 64 + lane] * hst + EX[512 + wp * 64 + lane];
        }
        float xm3 = 0.f, xm2 = 0.f, xm1 = 0.f;
        if (l0 > 0) { xm3 = bf2f(PROJ[(tbase - 3) * 1536 + 512 + ch]); xm2 = bf2f(PROJ[(tbase - 2) * 1536 + 512 + ch]); xm1 = bf2f(PROJ[(tbase - 1) * 1536 + 512 + ch]); }
        for (int sb = 0; sb < 8; ++sb) {
            const size_t t0 = tbase + sb * 32;
            float xf[32];
#pragma unroll
            for (int t = 0; t < 32; ++t) { const float xc = bf2f(PROJ[(t0 + t) * 1536 + 512 + ch]);
                xf[t] = cw0 * xm3 + cw1 * xm2 + cw2 * xm1 + cw3 * xc + cb; xm3 = xm2; xm2 = xm1; xm1 = xc;
                XF[t * 72 + lane] = (bf16)f2bf(xf[t]); }
            LDS_WAIT(); CBAR();
            bf16x8 xb[4];
#pragma unroll
            for (int s = 0; s < 4; ++s) xb[s] = *(const LAS bf16x8*)(XF + r32 * 72 + 16 * s + 8 * hh);
            LDS_WAIT(); CBAR();
#pragma unroll
            for (int blk = 0; blk < 2; ++blk) {
                f32x16 ga = {}, gi = {};
#pragma unroll
                for (int s = 0; s < 4; ++s) { ga = __builtin_amdgcn_mfma_f32_32x32x16_bf16(fa[blk][s], xb[s], ga, 0, 0, 0); gi = __builtin_amdgcn_mfma_f32_32x32x16_bf16(fi[blk][s], xb[s], gi, 0, 0, 0); }
#pragma unroll
                for (int q = 0; q < 4; ++q) { *(LAS f32x4*)(GA + r32 * 68 + 32 * blk + 8 * q + 4 * hh) = (f32x4){ga[4 * q], ga[4 * q + 1], ga[4 * q + 2], ga[4 * q + 3]};
                                              *(LAS f32x4*)(GI + r32 * 68 + 32 * blk + 8 * q + 4 * hh) = (f32x4){gi[4 * q], gi[4 * q + 1], gi[4 * q + 2], gi[4 * q + 3]}; }
            }
            LDS_WAIT(); CBAR();
#pragma unroll
            for (int t = 0; t < 32; ++t) {
                const float ra = sigm(GA[t * 68 + lane] + ba), ri = sigm(GI[t * 68 + lane] + bi);
                const float la = ra * lsl8, av = __expf(la);
                const float bv = sqrtf(-expm1f(2.0f * la)) * (ri * xf[t]);
                hst = av * hst + bv;
                if (pass == 0) aprod *= av;
                else { const float gl = bf2f(PROJ[(t0 + t) * 1536 + 1024 + ch]); YCAT[(t0 + t) * 1024 + 512 + ch] = (bf16)f2bf(hst * gelu_tanh(gl)); }
            }
            LDS_WAIT(); CBAR();
        }
    }
    __syncthreads();
}
__device__ __forceinline__ void p2_mixers(const Frame& F, const Args& a) {
    if (PH(2)) for (int u = F.vcu; u < 256; u += F.G) s5_unit(F, a, u >> 5, u & 31);
    CBAR(); __syncthreads(); CBAR();
    if (PH(3)) for (int u = F.vcu; u < 64; u += F.G) lru_unit(F, a, u >> 3, u & 7);
}

__device__ __forceinline__ void norm_phase(const Frame& F, const float* xin, const float* gain, bf16* XN) {
    f32x4 g[4];
#pragma unroll
    for (int j = 0; j < 4; ++j) g[j] = *((const f32x4*)gain + F.lane + 64 * j);
    for (int m = F.gw; m < NT; m += F.ngw) { f32x4 v[4]; const f32x4* xr = (const f32x4*)(xin + (size_t)m * DM) + F.lane;
#pragma unroll
        for (int j = 0; j < 4; ++j) v[j] = xr[64 * j];
        norm_row(v, g, XN + (size_t)m * DM, F.lane); }
}
__device__ __forceinline__ void router_phase(const Frame& F, const Args& a, int layer) {
    const int lane = F.lane, r32 = lane & 31, hh = lane >> 5;
    LAS float* LG = (LAS float*)(F.lds + F.wave * WSCR);
    const bf16* XN = (const bf16*)(a.ws + WS_XN); const bf16* WrT = (const bf16*)(a.ws + WS_WR) + (size_t)layer * 96 * 1024;
    const float* bg = a.in[33] + layer * 8; const float* be = a.in[35] + layer * 64;
    unsigned* cnt = (unsigned*)(a.ws + WS_CTL) + CW_CNT + layer * 2048;
    int* TE = (int*)(a.ws + AR_TOK); float* TG = (float*)(a.ws + AR_TOK + 128 * 1024); int* TP = (int*)(a.ws + AR_TOK + 256 * 1024);
    for (int u = F.gw; u < NT / 32; u += F.ngw) {
        const size_t t0 = (size_t)u * 32;
        f32x16 acc[3] = {};
        const bf16* xp = XN + (t0 + r32) * DM + 8 * hh; const bf16* wp = WrT + (size_t)r32 * DM + 8 * hh;
#pragma unroll 4
        for (int s = 0; s < 64; ++s) {
            const bf16x8 xb = *(const bf16x8*)(xp + 16 * s);
#pragma unroll
            for (int blk = 0; blk < 3; ++blk) { const bf16x8 wa = *(const bf16x8*)(wp + (size_t)blk * 32 * DM + 16 * s); acc[blk] = __builtin_amdgcn_mfma_f32_32x32x16_bf16(wa, xb, acc[blk], 0, 0, 0); }
        }
#pragma unroll
        for (int blk = 0; blk < 3; ++blk)
#pragma unroll
            for (int q = 0; q < 4; ++q) *(LAS f32x4*)(LG + r32 * 100 + 32 * blk + 8 * q + 4 * hh) = (f32x4){acc[blk][4 * q], acc[blk][4 * q + 1], acc[blk][4 * q + 2], acc[blk][4 * q + 3]};
        LDS_WAIT(); CBAR();
        if (lane < 32) {
            const LAS float* row = LG + lane * 100;
            float gl[8]; float gmax = -3.0e38f; int gsel = 0;
#pragma unroll
            for (int i = 0; i < 8; ++i) { gl[i] = row[i] + bg[i]; if (gl[i] > gmax) { gmax = gl[i]; gsel = i; } }
            float gs = 0.f;
#pragma unroll
            for (int i = 0; i < 8; ++i) gs += __expf(gl[i] - gmax);
            const float pg = 1.0f / gs;
            float v1 = -3.0e38f, v2 = -3.0e38f; int i1 = 0, i2 = 0;
#pragma unroll
            for (int i = 0; i < 8; ++i) { const float v = row[8 + gsel * 8 + i] + be[gsel * 8 + i];
                if (v > v1) { v2 = v1; i2 = i1; v1 = v; i1 = i; } else if (v > v2) { v2 = v; i2 = i; } }
            const float e2 = __expf(v2 - v1), inv = 1.0f / (1.0f + e2);
            const int ea = gsel * 8 + i1, eb = gsel * 8 + i2;
            const size_t t = t0 + lane;
            const unsigned pa = atomicAdd(cnt + ea * 16, 1u), pb = atomicAdd(cnt + eb * 16, 1u);
            TE[2 * t] = ea; TE[2 * t + 1] = eb; TG[2 * t] = pg * inv; TG[2 * t + 1] = pg * e2 * inv; TP[2 * t] = (int)pa; TP[2 * t + 1] = (int)pb;
        }
        LDS_WAIT(); CBAR();
    }
}
__device__ __forceinline__ void scatter_phase(const Frame& F, const Args& a, int layer) {
    LAS int* PADS = (LAS int*)(F.lds + TAB_OFF);
    LAS int* TILE_E = PADS + 64;
    LAS int* NRT = TILE_E + MAX_RT;
    const unsigned* cnt = (const unsigned*)(a.ws + WS_CTL) + CW_CNT + layer * 2048;
    if (F.tid == 0) {
        int acc = 0;
        for (int e = 0; e < 64; ++e) { const int c = (int)__hip_atomic_load(cnt + e * 16, RLX_AGENT); const int nt = (c + 255) >> 8; PADS[e] = acc * 256; for (int j = 0; j < nt; ++j) TILE_E[acc + j] = e; acc += nt; }
        NRT[0] = acc;
    }
    __syncthreads();
    const bf16* XN = (const bf16*)(a.ws + WS_XN); bf16* XD = (bf16*)(a.ws + AR_XDISP);
    const int* TE = (const int*)(a.ws + AR_TOK); const int* TP = (const int*)(a.ws + AR_TOK + 256 * 1024); int* TD = (int*)(a.ws + AR_TOK + 384 * 1024);
    for (int t = F.gw; t < NT; t += F.ngw) {
        const int d0 = PADS[TE[2 * t]] + TP[2 * t], d1 = PADS[TE[2 * t + 1]] + TP[2 * t + 1];
        const v4u* src = (const v4u*)(XN + (size_t)t * DM) + F.lane; const v4u x0 = src[0], x1 = src[64];
        v4u* p0 = (v4u*)(XD + (size_t)d0 * DM) + F.lane; p0[0] = x0; p0[64] = x1;
        v4u* p1 = (v4u*)(XD + (size_t)d1 * DM) + F.lane; p1[0] = x0; p1[64] = x1;
        if (F.lane == 0) { TD[2 * t] = d0; TD[2 * t + 1] = d1; }
    }
}
template <bool NORM>
__device__ __forceinline__ void combine_phase(const Frame& F, const Args& a, const float* xin, float* xout, const float* gain, bf16* XN) {
    const bf16* YD = (const bf16*)(a.ws + AR_YDISP); const float* TG = (const float*)(a.ws + AR_TOK + 128 * 1024); const int* TD = (const int*)(a.ws + AR_TOK + 384 * 1024);
    f32x4 g[4];
    if (NORM) {
#pragma unroll
        for (int j = 0; j < 4; ++j) g[j] = *((const f32x4*)gain + F.lane + 64 * j); }
    for (int t = F.gw; t < NT; t += F.ngw) {
        const int d0 = TD[2 * t], d1 = TD[2 * t + 1]; const float g0 = TG[2 * t], g1 = TG[2 * t + 1];
        const f32x4* xr = (const f32x4*)(xin + (size_t)t * DM) + F.lane; const v2u* y0 = (const v2u*)(YD + (size_t)d0 * DM) + F.lane; const v2u* y1 = (const v2u*)(YD + (size_t)d1 * DM) + F.lane;
        f32x4 v[4];
#pragma unroll
        for (int j = 0; j < 4; ++j) { const f32x4 x = xr[64 * j]; const v2u a0 = y0[64 * j], a1 = y1[64 * j];
            v[j].x = x.x + g0 * bflo(a0.x) + g1 * bflo(a1.x); v[j].y = x.y + g0 * bfhi(a0.x) + g1 * bfhi(a1.x);
            v[j].z = x.z + g0 * bflo(a0.y) + g1 * bflo(a1.y); v[j].w = x.w + g0 * bfhi(a0.y) + g1 * bfhi(a1.y); }
        f32x4* xo = (f32x4*)(xout + (size_t)t * DM) + F.lane;
#pragma unroll
        for (int j = 0; j < 4; ++j) xo[64 * j] = v[j];
        if (NORM) norm_row(v, g, XN + (size_t)t * DM, F.lane);
    }
}

__device__ const float INV_FREQ[32] = {
    1.0f, 0.7498942093324559f, 0.5623413251903491f, 0.4216965034285822f, 0.31622776601683794f, 0.23713737056616552f, 0.1778279410038923f, 0.1333521432163324f,
    0.1f, 0.07498942093324558f, 0.05623413251903491f, 0.04216965034285822f, 0.031622776601683794f, 0.023713737056616554f, 0.01778279410038923f, 0.01333521432163324f,
    0.01f, 0.007498942093324558f, 0.005623413251903491f, 0.004216965034285822f, 0.0031622776601683794f, 0.0023713737056616554f, 0.001778279410038923f, 0.001333521432163324f,
    0.001f, 0.0007498942093324559f, 0.0005623413251903491f, 0.0004216965034285822f, 0.00031622776601683794f, 0.00023713737056616554f, 0.0001778279410038923f, 0.0001333521432163324f };
__device__ __forceinline__ void mla_lora_norm_phase(const Frame& F, const Args& a) {
    const bf16* CQR = (const bf16*)(a.ws + AR_CQR); const bf16* CKVR = (const bf16*)(a.ws + AR_CKVR);
    bf16* CQ = (bf16*)(a.ws + AR_CQ); bf16* CKV = (bf16*)(a.ws + AR_CKV); float* COS = (float*)(a.ws + AR_COS); float* SIN = (float*)(a.ws + AR_SIN);
    const float* gq = a.in[24]; const float* gkv = a.in[25];
    const int lane = F.lane;
    float gqv[6], gkvv[4];
#pragma unroll
    for (int j = 0; j < 6; ++j) gqv[j] = gq[lane + 64 * j];
#pragma unroll
    for (int j = 0; j < 4; ++j) gkvv[j] = gkv[lane + 64 * j];
    for (int t = F.gw; t < NT; t += F.ngw) {
        float q[6], k[4]; float sq = 0.f, sk = 0.f;
#pragma unroll
        for (int j = 0; j < 6; ++j) { q[j] = bf2f(CQR[(size_t)t * 384 + lane + 64 * j]); sq += q[j] * q[j]; }
#pragma unroll
        for (int j = 0; j < 4; ++j) { k[j] = bf2f(CKVR[(size_t)t * 256 + lane + 64 * j]); sk += k[j] * k[j]; }
        const float rq = rsqrtf(wave_sum(sq) * (1.f / 384.f) + RMS_EPS), rk = rsqrtf(wave_sum(sk) * (1.f / 256.f) + RMS_EPS);
#pragma unroll
        for (int j = 0; j < 6; ++j) CQ[(size_t)t * 384 + lane + 64 * j] = (bf16)f2bf(q[j] * rq * gqv[j]);
#pragma unroll
        for (int j = 0; j < 4; ++j) CKV[(size_t)t * 256 + lane + 64 * j] = (bf16)f2bf(k[j] * rk * gkvv[j]);
        if (lane < 32) {
            const float ang = (float)a.pos[t] * INV_FREQ[lane];
            const double tw = 6.283185307179586476925286766559; const double ad = (double)ang; const double nn = __builtin_rint(ad / tw); const float rr = (float)(ad - nn * tw);
            COS[(size_t)t * 32 + lane] = cosf(rr); SIN[(size_t)t * 32 + lane] = sinf(rr);
        }
    }
}
__device__ __forceinline__ void mla_qk_phase(const Frame& F, const Args& a) {
    const bf16* QRAW = (const bf16*)(a.ws + AR_QRAW); const bf16* KNRAW = (const bf16*)(a.ws + AR_KNRAW); const bf16* KRR = (const bf16*)(a.ws + AR_KRR);
    bf16* QF = (bf16*)(a.ws + AR_QF); bf16* KF = (bf16*)(a.ws + AR_KF); const float* COS = (const float*)(a.ws + AR_COS); const float* SIN = (const float*)(a.ws + AR_SIN);
    const int lane = F.lane;
    const float qn0 = a.in[28][lane], qn1 = a.in[28][64 + lane], qn2 = a.in[28][128 + lane];
    const float kn0 = a.in[29][lane], kn1 = a.in[29][64 + lane], kn2 = a.in[29][128 + lane];
    const float QS = 1.4426950408889634f * 0.07216878364870322f;
    for (int t = F.gw; t < NT; t += F.ngw) {
        const int b = t >> 11, l = t & 2047;
        const float cs = COS[(size_t)t * 32 + (lane & 31)], sn = SIN[(size_t)t * 32 + (lane & 31)];
        const float sgn = (lane < 32) ? -1.f : 1.f;
        const float kr = bf2f(KRR[(size_t)t * 64 + lane]);
#pragma unroll 2
        for (int h = 0; h < 8; ++h) {
            const bf16* qp = QRAW + (size_t)t * 1536 + h * 192;
            float q0 = bf2f(qp[lane]), q1 = bf2f(qp[64 + lane]), q2 = bf2f(qp[128 + lane]);
            const float rq = rsqrtf(wave_sum(q0 * q0 + q1 * q1 + q2 * q2) * (1.f / 192.f) + RMS_EPS);
            q0 *= rq * qn0; q1 *= rq * qn1; q2 *= rq * qn2;
            const float q2p = __shfl_xor(q2, 32); const float q2r = q2 * cs + sgn * q2p * sn;
            bf16* qo = QF + ((size_t)(b * 8 + h) * SL + l) * 192;
            qo[lane] = (bf16)f2bf(q0 * QS); qo[64 + lane] = (bf16)f2bf(q1 * QS); qo[128 + lane] = (bf16)f2bf(q2r * QS);
            const bf16* kp = KNRAW + (size_t)t * 1024 + h * 128;
            float k0 = bf2f(kp[lane]), k1 = bf2f(kp[64 + lane]), k2 = kr;
            const float rk = rsqrtf(wave_sum(k0 * k0 + k1 * k1 + k2 * k2) * (1.f / 192.f) + RMS_EPS);
            k0 *= rk * kn0; k1 *= rk * kn1; k2 *= rk * kn2;
            const float k2p = __shfl_xor(k2, 32); const float k2r = k2 * cs + sgn * k2p * sn;
            bf16* ko = KF + ((size_t)(b * 8 + h) * SL + l) * 192;
            ko[lane] = (bf16)f2bf(k0); ko[64 + lane] = (bf16)f2bf(k1); ko[128 + lane] = (bf16)f2bf(k2r);
        }
    }
}

constexpr int AT_KB = 64 * 400, AT_VB = 128 * 136, AT_VOFF = 2 * AT_KB;
__device__ __forceinline__ void attn_block(const Frame& F, const Args& a, int b, int h, int qb) {
    const int tid = F.tid, lane = F.lane, w = F.wave, r32 = lane & 31, hh = lane >> 5;
    const bf16* QF = (const bf16*)(a.ws + AR_QF); const bf16* KF = (const bf16*)(a.ws + AR_KF); const bf16* VT = (const bf16*)(a.ws + AR_VT); bf16* O = (bf16*)(a.ws + AR_O);
    LAS unsigned char* lds = F.lds;
    const int q0 = qb * 256, qrow0 = q0 + 32 * w, nt = 4 * (qb + 1);
    const bf16* Kg = KF + (size_t)(b * 8 + h) * SL * 192;
    const bf16* Vg = VT + (size_t)(h * 128) * NT + (size_t)b * SL;
    bf16x8 qf[12];
    { const bf16* qp = QF + ((size_t)(b * 8 + h) * SL + qrow0 + r32) * 192 + 8 * hh;
#pragma unroll
      for (int s = 0; s < 12; ++s) qf[s] = *(const bf16x8*)(qp + 16 * s); }
    f32x16 o[4] = {};
    float mrun = -1e30f, lrun = 0.f;
    v4u kreg[3], vreg[2];
#define AT_LOAD(j) do { const bf16* kt = Kg + (size_t)(j) * 64 * 192; \
        _Pragma("unroll") for (int i = 0; i < 3; ++i) kreg[i] = *(const v4u*)(kt + (size_t)(tid + 512 * i) * 8); \
        _Pragma("unroll") for (int i = 0; i < 2; ++i) { const int c = tid + 512 * i; vreg[i] = *(const v4u*)(Vg + (size_t)(c >> 3) * NT + (j) * 64 + (c & 7) * 8); } } while (0)
#define AT_STORE(bf) do { _Pragma("unroll") for (int i = 0; i < 3; ++i) { const int c = tid + 512 * i; *(LAS v4u*)(lds + (bf) * AT_KB + (c / 24) * 400 + (c % 24) * 16) = kreg[i]; } \
        _Pragma("unroll") for (int i = 0; i < 2; ++i) { const int c = tid + 512 * i; LAS v2u* p = (LAS v2u*)(lds + AT_VOFF + (bf) * AT_VB + (c >> 3) * 136 + (c & 7) * 16); p[0] = (v2u){vreg[i].x, vreg[i].y}; p[1] = (v2u){vreg[i].z, vreg[i].w}; } } while (0)
    AT_LOAD(0);
    for (int j = 0; j < nt; ++j) {
        const int bf = j & 1;
        AT_STORE(bf);
        LDS_WAIT(); __syncthreads();
        if (j + 1 < nt) AT_LOAD(j + 1);
        if (j * 64 <= qrow0 + 31) {
            f32x16 p0 = {}, p1 = {};
            const LAS unsigned char* kb = lds + bf * AT_KB + r32 * 400 + hh * 16;
#pragma unroll
            for (int s = 0; s < 12; ++s) {
                const bf16x8 a0 = *(const LAS bf16x8*)(kb + 32 * s), a1 = *(const LAS bf16x8*)(kb + 32 * 400 + 32 * s);
                p0 = __builtin_amdgcn_mfma_f32_32x32x16_bf16(a0, qf[s], p0, 0, 0, 0);
                p1 = __builtin_amdgcn_mfma_f32_32x32x16_bf16(a1, qf[s], p1, 0, 0, 0);
            }
            if (j * 64 + 63 > qrow0) {
                const int qpos = qrow0 + r32, kbase = j * 64 + 4 * hh;
#pragma unroll
                for (int r = 0; r < 16; ++r) { const int kk = kbase + (r & 3) + 8 * (r >> 2);
                    if (kk > qpos) p0[r] = -__builtin_inff();
                    if (kk + 32 > qpos) p1[r] = -__builtin_inff(); }
            }
            float mx = p0[0];
#pragma unroll
            for (int r = 1; r < 16; ++r) mx = fmaxf(mx, p0[r]);
#pragma unroll
            for (int r = 0; r < 16; ++r) mx = fmaxf(mx, p1[r]);
            mx = fmaxf(mx, __shfl_xor(mx, 32));
            const float mn = fmaxf(mrun, mx), alpha = __builtin_amdgcn_exp2f(mrun - mn); mrun = mn;
            float ps = 0.f;
#pragma unroll
            for (int r = 0; r < 16; ++r) { p0[r] = __builtin_amdgcn_exp2f(p0[r] - mn); ps += p0[r]; }
#pragma unroll
            for (int r = 0; r < 16; ++r) { p1[r] = __builtin_amdgcn_exp2f(p1[r] - mn); ps += p1[r]; }
            ps += __shfl_xor(ps, 32);
            lrun = lrun * alpha + ps;
#pragma unroll
            for (int d = 0; d < 4; ++d)
#pragma unroll
                for (int r = 0; r < 16; ++r) o[d][r] *= alpha;
            bf16x8 pb[4];
            { v4u x;
              x.x = pg8::cvt_pk_bf16(p0[0], p0[1]); x.y = pg8::cvt_pk_bf16(p0[2], p0[3]); x.z = pg8::cvt_pk_bf16(p0[4], p0[5]); x.w = pg8::cvt_pk_bf16(p0[6], p0[7]); pb[0] = __builtin_bit_cast(bf16x8, x);
              x.x = pg8::cvt_pk_bf16(p0[8], p0[9]); x.y = pg8::cvt_pk_bf16(p0[10], p0[11]); x.z = pg8::cvt_pk_bf16(p0[12], p0[13]); x.w = pg8::cvt_pk_bf16(p0[14], p0[15]); pb[1] = __builtin_bit_cast(bf16x8, x);
              x.x = pg8::cvt_pk_bf16(p1[0], p1[1]); x.y = pg8::cvt_pk_bf16(p1[2], p1[3]); x.z = pg8::cvt_pk_bf16(p1[4], p1[5]); x.w = pg8::cvt_pk_bf16(p1[6], p1[7]); pb[2] = __builtin_bit_cast(bf16x8, x);
              x.x = pg8::cvt_pk_bf16(p1[8], p1[9]); x.y = pg8::cvt_pk_bf16(p1[10], p1[11]); x.z = pg8::cvt_pk_bf16(p1[12], p1[13]); x.w = pg8::cvt_pk_bf16(p1[14], p1[15]); pb[3] = __builtin_bit_cast(bf16x8, x); }
            const LAS unsigned char* vb = lds + AT_VOFF + bf * AT_VB + r32 * 136 + hh * 8;
#pragma unroll
            for (int d = 0; d < 4; ++d)
#pragma unroll
                for (int s = 0; s < 4; ++s) {
                    const LAS unsigned char* vp = vb + d * 32 * 136 + s * 32;
                    const v2u lo = *(const LAS v2u*)vp, hi = *(const LAS v2u*)(vp + 16);
                    const v4u av = {lo.x, lo.y, hi.x, hi.y};
                    o[d] = __builtin_amdgcn_mfma_f32_32x32x16_bf16(__builtin_bit_cast(bf16x8, av), pb[s], o[d], 0, 0, 0);
                }
        }
    }
#undef AT_LOAD
#undef AT_STORE
    const float inv = 1.0f / lrun;
    bf16* op = O + ((size_t)b * SL + qrow0 + r32) * 1024 + h * 128 + 4 * hh;
#pragma unroll
    for (int d = 0; d < 4; ++d)
#pragma unroll
        for (int q = 0; q < 4; ++q) { v2u wv; wv.x = pk2(o[d][4 * q] * inv, o[d][4 * q + 1] * inv); wv.y = pk2(o[d][4 * q + 2] * inv, o[d][4 * q + 3] * inv);
            *(v2u*)(op + 32 * d + 8 * q) = wv; }
    __syncthreads();
}
__device__ __forceinline__ void attn_phase(const Frame& F, const Args& a) {
    for (int u = F.vcu; u < 256; u += F.G) {
        const int bh = u >> 2, x = u & 3;
        attn_block(F, a, bh >> 3, bh & 7, 7 - x);
        attn_block(F, a, bh >> 3, bh & 7, x);
    }
}

__device__ __forceinline__ void copy_out(const Frame& F, const float* src, float* dst) {
    for (size_t i = (size_t)F.gw * 64 + F.lane; i < (size_t)NT * DM / 4; i += (size_t)F.ngw * 64) ((f32x4*)dst)[i] = ((const f32x4*)src)[i];
}
template <int LAYER>
__device__ __forceinline__ void moe_block(const Frame& F, const Args& a, const XcdBarrier& bar) {
    unsigned char* ws = a.ws; PG8_LAS unsigned char* ring = (PG8_LAS unsigned char*)F.lds;
    float* const OUT = a.out; float* const X2 = (float*)(ws + WS_X2); bf16* const XN = (bf16*)(ws + WS_XN);
    if (PH(6)) norm_phase(F, OUT, a.in[31] + LAYER * 1024, XN);
    xcd_barrier(bar);
    if (PH(7)) router_phase(F, a, LAYER);
    xcd_barrier(bar);
    if (PH(8)) scatter_phase(F, a, LAYER);
    xcd_barrier(bar);
    if (PH(9)) {
        pg8::GroupedOrder S{(const PG8_LAS int*)(F.lds + TAB_OFF + 256), ((const LAS int*)(F.lds + TAB_OFF))[64 + MAX_RT], 2, F.G, F.vcu};
        pg8::Gemm g{(const bf16*)(ws + AR_XDISP), (const bf16*)(ws + WS_W13), MAX_RT * 256, 64 * 512, 1024};
        pg8::EpiSwiGlu E{(bf16*)(ws + AR_H)};
        pg8::gemm_phase<pg8::EpiSwiGlu, pg8::GroupedOrder>(ring, g, S, E, nullptr);
    }
    xcd_barrier(bar);
    if (PH(10)) {
        pg8::GroupedOrder S{(const PG8_LAS int*)(F.lds + TAB_OFF + 256), ((const LAS int*)(F.lds + TAB_OFF))[64 + MAX_RT], 4, F.G, F.vcu};
        int k2 = 256; asm volatile("" : "+s"(k2));
        pg8::Gemm g{(const bf16*)(ws + AR_H), (const bf16*)(ws + WS_W2), MAX_RT * 256, 64 * 1024, k2};
        pg8::EpiBf16N E{(bf16*)(ws + AR_YDISP), 1024, 4};
        pg8::gemm_phase<pg8::EpiBf16N, pg8::GroupedOrder>(ring, g, S, E, nullptr);
    }
    xcd_barrier(bar);
    if (PH(17)) { if (LAYER == 0) combine_phase<true>(F, a, OUT, X2, a.in[22], XN); else combine_phase<false>(F, a, OUT, OUT, nullptr, nullptr); }
}
__global__ void __launch_bounds__(NWAVES * 64, 2) fwd_kernel(Args a) {
    extern __shared__ __attribute__((aligned(16))) unsigned char lds_raw[];
    Frame F;
    F.lds = (LAS unsigned char*)lds_raw;
    F.tid = threadIdx.x; F.lane = F.tid & 63; F.wave = __builtin_amdgcn_readfirstlane(F.tid >> 6);
    F.G = gridDim.x; { const int bx = blockIdx.x; F.vcu = (F.G % 8 == 0) ? (bx % 8) * (F.G / 8) + bx / 8 : bx; }
    F.gw = F.vcu * NWAVES + F.wave; F.ngw = F.G * NWAVES;
    volatile LAS unsigned* MISC = (volatile LAS unsigned*)(F.lds + MISC_OFF);
    for (int u = F.tid; u < (LDS_BYTES - TAB_OFF) / 4; u += NWAVES * 64) ((LAS unsigned*)(F.lds + TAB_OFF))[u] = 0u;
    __syncthreads();
    unsigned char* ws = a.ws;
    XcdBarrier bar = xcd_barrier_post((unsigned*)(ws + WS_CTL) + CW_BAR, MISC + 8);
#define GRID_BAR() xcd_barrier(bar)
    PG8_LAS unsigned char* ring = (PG8_LAS unsigned char*)F.lds;
    const int G = F.G, bx = (int)blockIdx.x;
    float* const OUT = a.out; float* const X2 = (float*)(ws + WS_X2); bf16* const XN = (bf16*)(ws + WS_XN);

    if (PH(0)) p0_prologue(F, a);
    GRID_BAR();
    if (PH(1)) {
        pg8::Gemm g{XN, (const bf16*)(ws + WS_WIN), NT, 1536, 1024}; pg8::StaticOrder S; S.init(NT, 1536, G, bx);
        pg8::EpiBf16N E{(bf16*)(ws + AR_PROJ), 1536, 1 << 20};
        pg8::gemm_phase<pg8::EpiBf16N, pg8::StaticOrder>(ring, g, S, E, nullptr);
    }
    GRID_BAR();
    p2_mixers(F, a);
    GRID_BAR();
    if (PH(4)) {
        pg8::Gemm g{(const bf16*)(ws + AR_YAPRE), (const bf16*)(ws + WS_GLU), NT, 512, 512}; pg8::StaticOrder S; S.init(NT, 512, G, bx);
        pg8::EpiGlu E{(const bf16*)(ws + AR_YAPRE), 512, (bf16*)(ws + AR_YCAT), 1024, a.in[13]};
        pg8::gemm_phase<pg8::EpiGlu, pg8::StaticOrder>(ring, g, S, E, nullptr);
    }
    GRID_BAR();
    if (PH(5)) {
        pg8::Gemm g{(const bf16*)(ws + AR_YCAT), (const bf16*)(ws + WS_WOUT), NT, 1024, 1024}; pg8::StaticOrder S; S.init(NT, 1024, G, bx);
        pg8::EpiResF32 E{a.in[0], OUT, 1024};
        pg8::gemm_phase<pg8::EpiResF32, pg8::StaticOrder>(ring, g, S, E, nullptr);
    }
    if (STOP_AFTER <= 5) return;
    GRID_BAR();
    moe_block<0>(F, a, bar);
    if (STOP_AFTER <= 10) { GRID_BAR(); copy_out(F, X2, OUT); return; }
    GRID_BAR();
    if (PH(11)) {
        pg8::Gemm g{XN, (const bf16*)(ws + WS_MIN), NT, 768, 1024}; pg8::StaticOrder S; S.init(NT, 768, G, bx);
        pg8::EpiMlaIn E{(bf16*)(ws + AR_CQR), (bf16*)(ws + AR_CKVR), (bf16*)(ws + AR_KRR)};
        pg8::gemm_phase<pg8::EpiMlaIn, pg8::StaticOrder>(ring, g, S, E, nullptr);
    }
    GRID_BAR();
    if (PH(12)) { mla_lora_norm_phase(F, a); conv_moe(F, a, 1, (LAS float*)(F.lds + F.wave * WSCR)); }
    GRID_BAR();
    if (PH(13)) {
        { pg8::Gemm g{(const bf16*)(ws + AR_CQ), (const bf16*)(ws + WS_UQ), NT, 1536, 384}; pg8::StaticOrder S; S.init(NT, 1536, G, bx);
          pg8::EpiBf16N E{(bf16*)(ws + AR_QRAW), 1536, 1 << 20}; pg8::gemm_phase<pg8::EpiBf16N, pg8::StaticOrder>(ring, g, S, E, nullptr); }
        CBAR(); __syncthreads(); CBAR();
        { pg8::Gemm g{(const bf16*)(ws + AR_CKV), (const bf16*)(ws + WS_UK), NT, 1024, 256}; pg8::StaticOrder S; S.init(NT, 1024, G, bx);
          pg8::EpiBf16N E{(bf16*)(ws + AR_KNRAW), 1024, 1 << 20}; pg8::gemm_phase<pg8::EpiBf16N, pg8::StaticOrder>(ring, g, S, E, nullptr); }
        CBAR(); __syncthreads(); CBAR();
        { pg8::Gemm g{(const bf16*)(ws + WS_UV), (const bf16*)(ws + AR_CKV), 1024, NT, 256}; pg8::StaticOrder S; S.init(1024, NT, G, bx);
          pg8::EpiBf16N E{(bf16*)(ws + AR_VT), NT, 1 << 20}; pg8::gemm_phase<pg8::EpiBf16N, pg8::StaticOrder>(ring, g, S, E, nullptr); }
    }
    GRID_BAR();
    if (PH(14)) mla_qk_phase(F, a);
    GRID_BAR();
    if (PH(15)) attn_phase(F, a);
    GRID_BAR();
    if (PH(16)) {
        pg8::Gemm g{(const bf16*)(ws + AR_O), (const bf16*)(ws + WS_WO), NT, 1024, 1024}; pg8::StaticOrder S; S.init(NT, 1024, G, bx);
        pg8::EpiResF32 E{X2, OUT, 1024};
        pg8::gemm_phase<pg8::EpiResF32, pg8::StaticOrder>(ring, g, S, E, nullptr);
    }
    if (STOP_AFTER <= 16) return;
    GRID_BAR();
    moe_block<1>(F, a, bar);
}

extern "C" void kernel_launch(void* const* d_in, const int* in_sizes, int n_in, void* d_out, int out_size, void* d_ws, size_t ws_size, hipStream_t stream) {
    static int grid = 0;
    if (grid == 0) {
        if (n_in != 39 || out_size != NT * DM || ws_size < WS_END) { fprintf(stderr, "kernel_launch: unexpected shapes (n_in %d out %d ws %zu, need %zu)\n", n_in, out_size, ws_size, (size_t)WS_END); grid = -1; return; }
        int dev = 0, cus = 0, per_cu = 0;
        if (hipGetDevice(&dev) != hipSuccess || hipDeviceGetAttribute(&cus, hipDeviceAttributeMultiprocessorCount, dev) != hipSuccess) { grid = -1; return; }
        if (hipFuncSetAttribute((const void*)fwd_kernel, hipFuncAttributeMaxDynamicSharedMemorySize, LDS_BYTES) != hipSuccess) { fprintf(stderr, "kernel_launch: hipFuncSetAttribute failed\n"); grid = -1; return; }
        if (hipOccupancyMaxActiveBlocksPerMultiprocessor(&per_cu, (const void*)fwd_kernel, NWAVES * 64, LDS_BYTES) != hipSuccess || per_cu < 1) { fprintf(stderr, "kernel_launch: occupancy query says %d\n", per_cu); }
        (void)hipGetLastError();
        grid = cus;
    }
    if (grid < 0) return;
    (void)hipMemsetAsync((char*)d_ws + WS_CTL, 0, CTL_ZERO_BYTES, stream);
    Args a{};
    for (int i = 0; i < 39; ++i) a.in[i] = (const float*)d_in[i];
    a.pos = (const int*)d_in[1]; a.out = (float*)d_out; a.ws = (unsigned char*)d_ws;
    hipLaunchKernelGGL(fwd_kernel, dim3(grid), dim3(NWAVES * 64), LDS_BYTES, stream, a);
}
```

```cpp
#include <hip/hip_runtime.h>
#include <cstdio>
#include <cstdint>
namespace pg8 {
#define PG8_LAS __attribute__((address_space(3)))
typedef unsigned short bf16_t;
typedef short bf16x8 __attribute__((ext_vector_type(8)));
typedef float f32x4 __attribute__((ext_vector_type(4)));
typedef unsigned u32x4 __attribute__((ext_vector_type(4)));
constexpr int BM = 256, BK = 64, HALF = 128, HTB = HALF * BK * 2  , STAGE_BYTES = 8 * HTB, NXCD = 8, WGM = 8;

__host__ __device__ __forceinline__ int lds_byte(int r, int c) { const int st = (r >> 4) * 2 + (c >> 5), rr = r & 15, cc = c & 31, ob = rr * 64 + cc * 2; return st * 1024 + (ob ^ (((ob >> 9) & 1) << 5)); }
__host__ __device__ __forceinline__ void stage_rc(int b, int& R, int& C) { const int st = b / 1024, sb = b % 1024, swz = sb ^ (((sb >> 9) & 1) << 5); R = (st >> 1) * 16 + swz / 64; C = (st & 1) * 32 + (swz % 64) / 2; }
__host__ __device__ __forceinline__ int perm32(int rho) { const int n = rho >> 4, i = rho & 15; return 8 * (i >> 2) + 4 * n + (i & 3); }

struct Unit { int pm, pn; };
struct Gemm { const bf16_t* A; const bf16_t* Bt; int M, N, K; };

struct StaticOrder {
    int nM, nN, nwg, G, c;
    __host__ __device__ void init(int M, int N, int G_, int c_) { nM = M / BM; nN = N / BM; nwg = nM * nN; G = G_; c = c_; }
    __host__ __device__ bool next(int i, Unit& u) const {
        const long L = (long)i * G + c; if (L >= nwg) return false;
        int wgid = (int)L; { const int q = nwg / NXCD, r = nwg % NXCD, xcd = wgid % NXCD, off = wgid / NXCD; wgid = (xcd < r ? xcd * (q + 1) : r * (q + 1) + (xcd - r) * q) + off; }
        const int nig = WGM * nN, gid = wgid / nig, fm = gid * WGM, gsz = (nM - fm) < WGM ? (nM - fm) : WGM;
        u.pm = fm + ((wgid % nig) % gsz); u.pn = (wgid % nig) / gsz; return true;
    }
    __device__ __forceinline__ void a_ready(const Unit&) const {}
    __device__ __forceinline__ void done(const Unit&) const {}
};
struct CountedOrder : StaticOrder {
    const unsigned* ready; unsigned need; unsigned* tmo;
    __device__ __forceinline__ void a_ready(const Unit& u) const {
        if (threadIdx.x < 64) {
            const unsigned long long t0 = __builtin_amdgcn_s_memrealtime(); unsigned polls = 0;
            while ((unsigned)__builtin_amdgcn_readfirstlane(__hip_atomic_load(ready + 64 * u.pm, __ATOMIC_RELAXED, __HIP_MEMORY_SCOPE_AGENT)) < need) {
                if ((++polls & 255u) == 0u && __builtin_amdgcn_readfirstlane(__hip_atomic_load(tmo, __ATOMIC_RELAXED, __HIP_MEMORY_SCOPE_AGENT)) != 0u) break;
                if (__builtin_amdgcn_s_memrealtime() - t0 > 2000000ull) {
                    if (threadIdx.x == 0) { unsigned expect = 0u; __hip_atomic_compare_exchange_strong(tmo + 1, &expect, 0x600u | (unsigned)(u.pm & 0xff), __ATOMIC_RELAXED, __ATOMIC_RELAXED, __HIP_MEMORY_SCOPE_AGENT); __hip_atomic_store(tmo, 1u, __ATOMIC_RELAXED, __HIP_MEMORY_SCOPE_AGENT); }
                    break; }
                __builtin_amdgcn_s_sleep(2); }
            __builtin_amdgcn_fence(__ATOMIC_ACQUIRE, "agent");
            asm volatile("s_waitcnt vmcnt(0)" ::: "memory");
        }
#if !defined(BROKEN_HOOK_NO_BARRIER)
        asm volatile("" ::: "memory"); __builtin_amdgcn_s_barrier(); asm volatile("" ::: "memory");
#endif
    }
};

__device__ __forceinline__ unsigned cvt_pk_bf16(float lo, float hi) { unsigned r; asm volatile("v_cvt_pk_bf16_f32 %0, %1, %2" : "=v"(r) : "v"(lo), "v"(hi)); return r; }
typedef float f32x2 __attribute__((ext_vector_type(2)));
__device__ __forceinline__ f32x2 gelu_pk(f32x2 v) {
    const f32x2 av = __builtin_elementwise_abs(v), d = av * 0.2316418882f + 1.0f;
    f32x2 t; t.x = __builtin_amdgcn_rcpf(d.x); t.y = __builtin_amdgcn_rcpf(d.y);
    f32x2 q = t * 0.5307027145f + (-0.7265760135f); q = q * t + 0.7107068705f; q = q * t + (-0.142248368f); q = q * t + 0.127414796f; q = q * t;
    const f32x2 s = (v * v) * (-0.72134752044f);
    f32x2 e; e.x = __builtin_amdgcn_exp2f(s.x); e.y = __builtin_amdgcn_exp2f(s.y);
    const f32x2 m = v * (q * e), r = v - m;
    f32x2 o; o.x = v.x < 0.f ? m.x : r.x; o.y = v.y < 0.f ? m.y : r.y; return o;
}

struct EpiF32 {
    static constexpr bool PERM = false, AFTER_DRAIN = false;
    float* C; int ldc; const float* bias;
    __device__ __forceinline__ void operator()(const f32x4 (&acc)[2][2][4][2], const Unit& u, int wr, int wc, int fr, int fq) const {
        const int row0 = u.pm * BM + wr * 64 + fr, col0 = u.pn * BM + wc * 32 + 4 * fq;
        f32x4 bv[2][2];
#pragma unroll
        for (int bj = 0; bj < 2; ++bj)
#pragma unroll
            for (int n = 0; n < 2; ++n) bv[bj][n] = bias ? *(const f32x4*)(bias + col0 + bj * HALF + n * 16) : (f32x4){0.f, 0.f, 0.f, 0.f};
#pragma unroll
        for (int ai = 0; ai < 2; ++ai)
#pragma unroll
            for (int m = 0; m < 4; ++m) { float* rowp = C + (size_t)(row0 + ai * HALF + m * 16) * ldc + col0;
#pragma unroll
                for (int bj = 0; bj < 2; ++bj)
#pragma unroll
                    for (int n = 0; n < 2; ++n) *(f32x4*)(rowp + bj * HALF + n * 16) = acc[ai][bj][m][n] + bv[bj][n]; }
    }
};
template <int ACT  > struct EpiBf16 {
    static constexpr bool PERM = true, AFTER_DRAIN = false;
    bf16_t* O; int ldc; const float* bias; int split_cols; size_t split_stride;
    __device__ __forceinline__ void operator()(const f32x4 (&acc)[2][2][4][2], const Unit& u, int wr, int wc, int fr, int fq) const {
        const int row0 = u.pm * BM + wr * 64 + fr; int colt = u.pn * BM; bf16_t* base = O;
        if (split_cols) { const int t = colt / split_cols; base += (size_t)t * split_stride; colt -= t * split_cols; }
        const int col0 = colt + wc * 32 + 8 * fq, bcol0 = u.pn * BM + wc * 32 + 8 * fq;
        f32x4 bv[2][2];
#pragma unroll
        for (int bj = 0; bj < 2; ++bj)
#pragma unroll
            for (int n = 0; n < 2; ++n) bv[bj][n] = bias ? *(const f32x4*)(bias + bcol0 + bj * HALF + 4 * n) : (f32x4){0.f, 0.f, 0.f, 0.f};
#pragma unroll
        for (int ai = 0; ai < 2; ++ai)
#pragma unroll
            for (int m = 0; m < 4; ++m) { bf16_t* rowp = base + (size_t)(row0 + ai * HALF + m * 16) * ldc + col0;
#pragma unroll
                for (int bj = 0; bj < 2; ++bj) { f32x4 v0 = acc[ai][bj][m][0] + bv[bj][0], v1 = acc[ai][bj][m][1] + bv[bj][1];
                    if (ACT == 1) { f32x2 a = gelu_pk((f32x2){v0[0], v0[1]}), b = gelu_pk((f32x2){v0[2], v0[3]}), c = gelu_pk((f32x2){v1[0], v1[1]}), d = gelu_pk((f32x2){v1[2], v1[3]});
                        v0 = (f32x4){a.x, a.y, b.x, b.y}; v1 = (f32x4){c.x, c.y, d.x, d.y}; }
                    if (ACT == 2) {
#pragma unroll
                        for (int j = 0; j < 4; ++j) { v0[j] = 0.5f * v0[j] * (1.0f + erff(v0[j] * 0.70710678f)); v1[j] = 0.5f * v1[j] * (1.0f + erff(v1[j] * 0.70710678f)); } }
                    u32x4 w; w.x = cvt_pk_bf16(v0[0], v0[1]); w.y = cvt_pk_bf16(v0[2], v0[3]); w.z = cvt_pk_bf16(v1[0], v1[1]); w.w = cvt_pk_bf16(v1[2], v1[3]);
                    *(u32x4*)(rowp + bj * HALF) = w; } }
    }
};
__device__ __forceinline__ float bf2f(unsigned b16) { return __uint_as_float(b16 << 16); }
__device__ __forceinline__ float bflo(unsigned w) { return __uint_as_float(w << 16); }
__device__ __forceinline__ float bfhi(unsigned w) { return __uint_as_float(w & 0xffff0000u); }
__device__ __forceinline__ float sigm(float x) { return 1.0f / (1.0f + __expf(-x)); }

struct EpiResF32 {
    static constexpr bool PERM = false, AFTER_DRAIN = false;
    const float* res; float* out; int ldc;
    __device__ __forceinline__ void operator()(const f32x4 (&acc)[2][2][4][2], const Unit& u, int wr, int wc, int fr, int fq) const {
        const int row0 = u.pm * BM + wr * 64 + fr, col0 = u.pn * BM + wc * 32 + 4 * fq;
#pragma unroll
        for (int ai = 0; ai < 2; ++ai)
#pragma unroll
            for (int m = 0; m < 4; ++m) { const size_t off = (size_t)(row0 + ai * HALF + m * 16) * ldc + col0;
#pragma unroll
                for (int bj = 0; bj < 2; ++bj)
#pragma unroll
                    for (int n = 0; n < 2; ++n) { const f32x4 r = *(const f32x4*)(res + off + bj * HALF + n * 16); *(f32x4*)(out + off + bj * HALF + n * 16) = acc[ai][bj][m][n] + r; } }
    }
};
struct EpiBf16N {
    static constexpr bool PERM = true, AFTER_DRAIN = false;
    bf16_t* O; int ldc; int nct;
    __device__ __forceinline__ void operator()(const f32x4 (&acc)[2][2][4][2], const Unit& u, int wr, int wc, int fr, int fq) const {
        const int row0 = u.pm * BM + wr * 64 + fr, col0 = (u.pn % nct) * BM + wc * 32 + 8 * fq;
#pragma unroll
        for (int ai = 0; ai < 2; ++ai)
#pragma unroll
            for (int m = 0; m < 4; ++m) { bf16_t* rowp = O + (size_t)(row0 + ai * HALF + m * 16) * ldc + col0;
#pragma unroll
                for (int bj = 0; bj < 2; ++bj) { const f32x4 v0 = acc[ai][bj][m][0], v1 = acc[ai][bj][m][1];
                    u32x4 w; w.x = cvt_pk_bf16(v0[0], v0[1]); w.y = cvt_pk_bf16(v0[2], v0[3]); w.z = cvt_pk_bf16(v1[0], v1[1]); w.w = cvt_pk_bf16(v1[2], v1[3]);
                    *(u32x4*)(rowp + bj * HALF) = w; } }
    }
};
struct EpiGlu {
    static constexpr bool PERM = true, AFTER_DRAIN = false;
    const bf16_t* Y; int ldy; bf16_t* O; int ldo; const float* bias;
    __device__ __forceinline__ void operator()(const f32x4 (&acc)[2][2][4][2], const Unit& u, int wr, int wc, int fr, int fq) const {
        const int row0 = u.pm * BM + wr * 64 + fr, col0 = u.pn * BM + wc * 32 + 8 * fq;
        f32x4 bv[2][2];
#pragma unroll
        for (int bj = 0; bj < 2; ++bj)
#pragma unroll
            for (int n = 0; n < 2; ++n) bv[bj][n] = *(const f32x4*)(bias + col0 + bj * HALF + 4 * n);
#pragma unroll
        for (int ai = 0; ai < 2; ++ai)
#pragma unroll
            for (int m = 0; m < 4; ++m) { const int r = row0 + ai * HALF + m * 16;
#pragma unroll
                for (int bj = 0; bj < 2; ++bj) { const int c = col0 + bj * HALF;
                    const u32x4 yv = *(const u32x4*)(Y + (size_t)r * ldy + c);
                    const f32x4 v0 = acc[ai][bj][m][0] + bv[bj][0], v1 = acc[ai][bj][m][1] + bv[bj][1];
                    u32x4 w;
                    w.x = cvt_pk_bf16(bflo(yv.x) * sigm(v0[0]), bfhi(yv.x) * sigm(v0[1]));
                    w.y = cvt_pk_bf16(bflo(yv.y) * sigm(v0[2]), bfhi(yv.y) * sigm(v0[3]));
                    w.z = cvt_pk_bf16(bflo(yv.z) * sigm(v1[0]), bfhi(yv.z) * sigm(v1[1]));
                    w.w = cvt_pk_bf16(bflo(yv.w) * sigm(v1[2]), bfhi(yv.w) * sigm(v1[3]));
                    *(u32x4*)(O + (size_t)r * ldo + c) = w; } }
    }
};
struct EpiSwiGlu {
    static constexpr bool PERM = true, AFTER_DRAIN = false;
    bf16_t* H;
    __device__ __forceinline__ void operator()(const f32x4 (&acc)[2][2][4][2], const Unit& u, int wr, int wc, int fr, int fq) const {
        const int row0 = u.pm * BM + wr * 64 + fr, col0 = (u.pn & 1) * HALF + wc * 32 + 8 * fq;
#pragma unroll
        for (int ai = 0; ai < 2; ++ai)
#pragma unroll
            for (int m = 0; m < 4; ++m) { const int r = row0 + ai * HALF + m * 16;
                float o[8];
#pragma unroll
                for (int n = 0; n < 2; ++n)
#pragma unroll
                    for (int i = 0; i < 4; ++i) { const float a1 = acc[ai][0][m][n][i], a3 = acc[ai][1][m][n][i]; o[4 * n + i] = a1 * sigm(a1) * a3; }
                u32x4 w; w.x = cvt_pk_bf16(o[0], o[1]); w.y = cvt_pk_bf16(o[2], o[3]); w.z = cvt_pk_bf16(o[4], o[5]); w.w = cvt_pk_bf16(o[6], o[7]);
                *(u32x4*)(H + (size_t)r * 256 + col0) = w; }
    }
};
struct EpiMlaIn {
    static constexpr bool PERM = true, AFTER_DRAIN = false;
    bf16_t* CQ; bf16_t* CKV; bf16_t* KR;
    __device__ __forceinline__ void operator()(const f32x4 (&acc)[2][2][4][2], const Unit& u, int wr, int wc, int fr, int fq) const {
        const int row0 = u.pm * BM + wr * 64 + fr, col0 = u.pn * BM + wc * 32 + 8 * fq;
#pragma unroll
        for (int ai = 0; ai < 2; ++ai)
#pragma unroll
            for (int m = 0; m < 4; ++m) { const int r = row0 + ai * HALF + m * 16;
#pragma unroll
                for (int bj = 0; bj < 2; ++bj) { const int c = col0 + bj * HALF; const f32x4 v0 = acc[ai][bj][m][0], v1 = acc[ai][bj][m][1];
                    u32x4 w; w.x = cvt_pk_bf16(v0[0], v0[1]); w.y = cvt_pk_bf16(v0[2], v0[3]); w.z = cvt_pk_bf16(v1[0], v1[1]); w.w = cvt_pk_bf16(v1[2], v1[3]);
                    if (c < 384) *(u32x4*)(CQ + (size_t)r * 384 + c) = w;
                    else if (c < 640) *(u32x4*)(CKV + (size_t)r * 256 + (c - 384)) = w;
                    else if (c < 704) *(u32x4*)(KR + (size_t)r * 64 + (c - 640)) = w; } }
    }
};
struct GroupedOrder {
    const PG8_LAS int* tile_e; int n_rt, nct, G, c;
    __device__ __forceinline__ bool next(int i, Unit& u) const {
        const int L = i * G + c; if (L >= n_rt * nct) return false;
        const int rt = L / nct, j = L - rt * nct; u.pm = rt; u.pn = tile_e[rt] * nct + j; return true; }
    __device__ __forceinline__ void a_ready(const Unit&) const {}
    __device__ __forceinline__ void done(const Unit&) const {}
};
template <class Epi, class Sched, bool STAMP = false>
__device__ __forceinline__ void gemm_phase(PG8_LAS unsigned char* lds, const Gemm g, const Sched& S, const Epi& E, unsigned long long* stamps) {
    int tid_ = threadIdx.x; asm volatile("" : "+v"(tid_));
    const int tid = tid_, wid = __builtin_amdgcn_readfirstlane(tid >> 6), lane = tid & 63, wr = wid >> 2, wc = wid & 3, fr = lane & 15, fq = lane >> 4;
    const int K = g.K, nt = K / BK;
    int ts_lo = 0, ts_hi = 0, nts = 0; const unsigned long long rt_entry = STAMP ? (unsigned long long)wall_clock64() : 0ull;
#define PG8_STAMP() do { if (STAMP && wid == 0 && nts < 64) { const unsigned long long _c = (unsigned long long)clock64(); \
        ts_lo = (lane == nts) ? (int)(unsigned)_c : ts_lo; ts_hi = (lane == nts) ? (int)(unsigned)(_c >> 32) : ts_hi; ++nts; } } while (0)
    PG8_STAMP();
    unsigned voffA[2], voffB[2];
#pragma unroll
    for (int i = 0; i < 2; ++i) { int R, C; stage_rc(tid * 16 + i * 8192, R, C); const int Rb = Epi::PERM ? ((R & ~31) + perm32(R & 31)) : R;
        voffA[i] = (unsigned)(R * K + C) * 2u; voffB[i] = (unsigned)(Rb * K + C) * 2u; }
    const size_t kstep = (size_t)(BK * 2);
    const size_t hstep = (size_t)HALF * K * 2;
    const size_t tstep = 2 * hstep;
    const unsigned ldsw = (unsigned)wid * 1024u;
    const int aoff = lds_byte(wr * 64 + fr, fq * 8), boff = lds_byte(wc * 32 + fr, fq * 8);
#define PG8_SA(b, h) (((b) * 2 + (h)) * HTB)
#define PG8_SB(b, h) ((4 + (b) * 2 + (h)) * HTB)
#define PG8_STAGE(bufoff, gbase, voff) do { _Pragma("unroll") for (int _i = 0; _i < 2; ++_i) \
        __builtin_amdgcn_global_load_lds((const unsigned*)((const char*)(gbase) + (voff)[_i]), (PG8_LAS unsigned*)(lds + (bufoff) + ldsw + _i * 8192), 16, 0, 0); } while (0)
#define PG8_LDA(dst, b, h) do { _Pragma("unroll") for (int m = 0; m < 4; ++m) _Pragma("unroll") for (int k = 0; k < 2; ++k) dst[m][k] = *(const PG8_LAS bf16x8*)(lds + PG8_SA(b, h) + aoff + m * 2048 + k * 1024); } while (0)
#define PG8_LDB(dst, b, h) do { _Pragma("unroll") for (int n = 0; n < 2; ++n) _Pragma("unroll") for (int k = 0; k < 2; ++k) dst[n][k] = *(const PG8_LAS bf16x8*)(lds + PG8_SB(b, h) + boff + n * 2048 + k * 1024); } while (0)
#define PG8_MMA(ai, bj, At, Bt) do { __builtin_amdgcn_s_setprio(1); _Pragma("unroll") for (int m = 0; m < 4; ++m) _Pragma("unroll") for (int n = 0; n < 2; ++n) _Pragma("unroll") for (int k = 0; k < 2; ++k) \
        acc[ai][bj][m][n] = __builtin_amdgcn_mfma_f32_16x16x32_bf16(Bt[n][k], At[m][k], acc[ai][bj][m][n], 0, 0, 0); __builtin_amdgcn_s_setprio(0); } while (0)
#define PG8_WAIT_V(n) asm volatile("s_waitcnt vmcnt(" #n ")" ::: "memory")
#define PG8_WAIT_L(n) asm volatile("s_waitcnt lgkmcnt(" #n ")" ::: "memory")
#define PG8_BAR __builtin_amdgcn_s_barrier()
#define PG8_SCHED __builtin_amdgcn_sched_barrier(0)
    Unit cur, nxt; int ui = 0;
    if (!S.next(0, cur)) return;
    f32x4 acc[2][2][4][2];
#pragma unroll
    for (int a = 0; a < 2; ++a)
#pragma unroll
        for (int b = 0; b < 2; ++b)
#pragma unroll
            for (int m = 0; m < 4; ++m)
#pragma unroll
                for (int n = 0; n < 2; ++n) acc[a][b][m][n] = (f32x4){0.f, 0.f, 0.f, 0.f};
    bf16x8 At[4][2], B0[2][2], B1[2][2];
    const char* cA = (const char*)g.A + (size_t)cur.pm * tstep; const char* cB = (const char*)g.Bt + (size_t)cur.pn * tstep;
    S.a_ready(cur);
    PG8_STAGE(PG8_SB(0, 0), cB, voffB); PG8_STAGE(PG8_SA(0, 0), cA, voffA); PG8_STAGE(PG8_SB(0, 1), cB + hstep, voffB); PG8_STAGE(PG8_SA(0, 1), cA + hstep, voffA);
    if (wr == 1) PG8_BAR;
    PG8_WAIT_V(4); PG8_BAR;
    PG8_STAGE(PG8_SB(1, 0), cB + kstep, voffB); PG8_STAGE(PG8_SA(1, 0), cA + kstep, voffA); PG8_STAGE(PG8_SB(1, 1), cB + hstep + kstep, voffB);
    PG8_WAIT_V(6); PG8_BAR;
    PG8_STAMP();
    for (;;) {
        const bool has_next = S.next(ui + 1, nxt);
        const char* nA = has_next ? (const char*)g.A + (size_t)nxt.pm * tstep : cA; const char* nB = has_next ? (const char*)g.Bt + (size_t)nxt.pn * tstep : cB;
        for (int t = 0; t < nt; t += 2) {
            const bool last = (t == nt - 2);
            const char* a1 = cA + (size_t)(t + 1) * kstep;
            const char* a2 = last ? nA : cA + (size_t)(t + 2) * kstep; const char* b2 = last ? nB : cB + (size_t)(t + 2) * kstep;
            const char* a3 = a2 + kstep; const char* b3 = b2 + kstep;
            if (last && has_next) S.a_ready(nxt);
            PG8_LDB(B0, 0, 0); PG8_SCHED; PG8_LDA(At, 0, 0); PG8_STAGE(PG8_SA(1, 1), a1 + hstep, voffA);
            PG8_WAIT_L(8); PG8_BAR; PG8_WAIT_L(0); PG8_MMA(0, 0, At, B0); PG8_BAR; PG8_SCHED;
            PG8_LDB(B1, 0, 1); PG8_STAGE(PG8_SB(0, 0), b2, voffB);
            PG8_BAR; PG8_WAIT_L(0); PG8_MMA(0, 1, At, B1); PG8_BAR;
            PG8_LDA(At, 0, 1); PG8_STAGE(PG8_SA(0, 0), a2, voffA);
            PG8_BAR; PG8_WAIT_L(0); PG8_MMA(1, 0, At, B0); PG8_BAR; PG8_SCHED;
            PG8_STAGE(PG8_SB(0, 1), b2 + hstep, voffB);
            PG8_WAIT_V(6); PG8_BAR; PG8_MMA(1, 1, At, B1); PG8_BAR;
            PG8_LDB(B0, 1, 0); PG8_SCHED; PG8_LDA(At, 1, 0); PG8_STAGE(PG8_SA(0, 1), a2 + hstep, voffA);
            PG8_WAIT_L(8); PG8_BAR; PG8_WAIT_L(0); PG8_MMA(0, 0, At, B0); PG8_BAR; PG8_SCHED;
            PG8_LDB(B1, 1, 1); PG8_STAGE(PG8_SB(1, 0), b3, voffB);
            PG8_BAR; PG8_WAIT_L(0); PG8_MMA(0, 1, At, B1); PG8_BAR;
            PG8_LDA(At, 1, 1); PG8_STAGE(PG8_SA(1, 0), a3, voffA);
            PG8_BAR; PG8_WAIT_L(0); PG8_MMA(1, 0, At, B0); PG8_BAR; PG8_SCHED;
            PG8_STAGE(PG8_SB(1, 1), b3 + hstep, voffB);
            PG8_WAIT_V(6); PG8_BAR; PG8_MMA(1, 1, At, B1); PG8_BAR;
        }
        PG8_STAMP();
        if constexpr (!Epi::AFTER_DRAIN) { E(acc, cur, wr, wc, fr, fq); S.done(cur); }
        PG8_STAMP();
        if (!has_next) break;
#pragma unroll
        for (int a = 0; a < 2; ++a)
#pragma unroll
            for (int b = 0; b < 2; ++b)
#pragma unroll
                for (int m = 0; m < 4; ++m)
#pragma unroll
                    for (int n = 0; n < 2; ++n) acc[a][b][m][n] = (f32x4){0.f, 0.f, 0.f, 0.f};
        cur = nxt; cA = nA; cB = nB; ++ui;
    }
    PG8_WAIT_V(0);
    if (wr == 0) PG8_BAR;
    PG8_BAR;
    if constexpr (Epi::AFTER_DRAIN) { E.fused(acc, cur, wr, wc, fr, fq, lds, wid, lane); S.done(cur); }
    PG8_STAMP();
    if (STAMP && wid == 0) { stamps[lane] = lane < nts ? (((unsigned long long)(unsigned)ts_hi << 32) | (unsigned)ts_lo) : 0ull;
        if (lane == 62) stamps[62] = rt_entry; if (lane == 63) stamps[63] = (unsigned long long)wall_clock64(); }
#undef PG8_STAMP
#undef PG8_SA
#undef PG8_SB
#undef PG8_STAGE
#undef PG8_LDA
#undef PG8_LDB
#undef PG8_MMA
#undef PG8_WAIT_V
#undef PG8_WAIT_L
#undef PG8_BAR
#undef PG8_SCHED
}
}
#ifndef STOP_AFTER
#define STOP_AFTER 99
#endif
#ifndef PH_MASK
#define PH_MASK 0xffffffffu
#endif
#define PH(k) ((PH_MASK >> (k)) & 1u)
#ifndef REP_MASK
#define REP_MASK 0u
#endif
#ifndef XBARS
#define XBARS 0
#endif
#define REPCNT(k) (((REP_MASK >> (k)) & 1u) ? 2 : 1)
#define RUNREP(k, stmt) do { stmt; if (REPCNT(k) == 2) { xcd_barrier(bar); stmt; } } while (0)
constexpr int NT = 16384, DM = 1024, NB = 8, SL = 2048;
constexpr int NWAVES = 8;
constexpr float RMS_EPS = 1e-6f;
constexpr size_t MiB = 1u << 20;
constexpr size_t WS_CTL = 0, CTL_ZERO_BYTES = 1 * MiB;
constexpr size_t WS_WIN = 1 * MiB;
constexpr size_t WS_GLU = 4 * MiB;
constexpr size_t WS_WOUT = WS_GLU + MiB / 2;
constexpr size_t WS_MIN = WS_WOUT + 2 * MiB;
constexpr size_t WS_UQ = 8 * MiB;
constexpr size_t WS_UK = WS_UQ + 5 * MiB / 4;
constexpr size_t WS_UV = WS_UK + MiB / 2;
constexpr size_t WS_WO = WS_UV + MiB / 2;
constexpr size_t WS_WR = WS_WO + 2 * MiB;
constexpr size_t WS_W13 = 13 * MiB;
constexpr size_t WS_W2 = 77 * MiB;
constexpr size_t WS_X2 = 109 * MiB;
constexpr size_t WS_XN = 173 * MiB;
constexpr size_t WS_AR = 205 * MiB;
constexpr size_t WS_END = WS_AR + 254 * MiB;
static_assert(WS_WR + 2 * 96 * 1024 * 2 <= WS_W13, "ws map");
constexpr size_t AR_PROJ = WS_AR, AR_YAPRE = WS_AR + 48 * MiB, AR_YCAT = WS_AR + 64 * MiB;
constexpr size_t AR_LRUC = WS_AR + 96 * MiB;
constexpr size_t AR_WAF = WS_AR + 97 * MiB;
constexpr size_t AR_XDISP = WS_AR, AR_H = WS_AR + 96 * MiB, AR_YDISP = WS_AR + 120 * MiB, AR_TOK = WS_AR + 216 * MiB;
constexpr int MAX_RT = 192;
constexpr size_t AR_CQR = WS_AR, AR_CKVR = WS_AR + 12 * MiB, AR_KRR = WS_AR + 20 * MiB, AR_COS = WS_AR + 22 * MiB, AR_SIN = WS_AR + 24 * MiB,
                 AR_CQ = WS_AR + 26 * MiB, AR_CKV = WS_AR + 38 * MiB, AR_QRAW = WS_AR + 46 * MiB, AR_KNRAW = WS_AR + 94 * MiB, AR_VT = WS_AR + 126 * MiB,
                 AR_QF = WS_AR + 158 * MiB, AR_KF = WS_AR + 206 * MiB, AR_O = AR_QRAW;
constexpr int CW_BAR = 4096, CW_CNT = 8192;
constexpr int RING_BYTES = 131072;
constexpr int WSCR = 17408;
constexpr int EX_OFF = 8 * WSCR;
constexpr int TAB_OFF = EX_OFF + 4096;
constexpr int MISC_OFF = TAB_OFF + 1280;
constexpr int LDS_BYTES = 147456;
static_assert(MISC_OFF + 128 <= LDS_BYTES, "LDS map");

#define GAS __attribute__((address_space(1)))
#define LAS __attribute__((address_space(3)))
typedef unsigned short bf16;
typedef unsigned v4u __attribute__((ext_vector_type(4)));
typedef unsigned v2u __attribute__((ext_vector_type(2)));
typedef float f32x4 __attribute__((ext_vector_type(4)));
typedef float f32x16 __attribute__((ext_vector_type(16)));
typedef short bf16x8 __attribute__((ext_vector_type(8)));
typedef GAS unsigned gu32;
#define RLX_AGENT __ATOMIC_RELAXED, __HIP_MEMORY_SCOPE_AGENT
#define LDS_WAIT() asm volatile("s_waitcnt lgkmcnt(0)" ::: "memory")
#define VM_WAIT() asm volatile("s_waitcnt vmcnt(0)" ::: "memory")
#define CBAR() asm volatile("" ::: "memory")
__device__ __forceinline__ unsigned f2bf(float f) { unsigned u = __builtin_bit_cast(unsigned, f); return (u + 0x7fffu + ((u >> 16) & 1u)) >> 16; }
__device__ __forceinline__ unsigned pk2(float lo, float hi) { return f2bf(lo) | (f2bf(hi) << 16); }
__device__ __forceinline__ float bf2f(unsigned b16) { return __uint_as_float(b16 << 16); }
__device__ __forceinline__ float bflo(unsigned w) { return __uint_as_float(w << 16); }
__device__ __forceinline__ float bfhi(unsigned w) { return __uint_as_float(w & 0xffff0000u); }
__device__ __forceinline__ float sigm(float x) { return 1.0f / (1.0f + __expf(-x)); }
__device__ __forceinline__ float gelu_tanh(float x) { const float z = 0.7978845608028654f * (x + 0.044715f * x * x * x); const float t = 1.0f - 2.0f / (1.0f + __expf(2.0f * z)); return 0.5f * x * (1.0f + t); }
__device__ __forceinline__ float wave_sum(float v) {
#pragma unroll
    for (int o = 1; o < 64; o <<= 1) v += __shfl_xor(v, o);
    return v;
}
__device__ __forceinline__ int crow(int r, int hi) { return (r & 3) + 8 * (r >> 2) + 4 * hi; }

#define XB_TMO      128
#define XB_XCNT(j)  (256  + 64 * (j))
#define XB_XSUB(j)  (1280 + 64 * (j))
#define XB_XGEN(j)  (2304 + 64 * (j))
#define XB_TOP      3328
#define XB_TOPGEN   3392
#define XCD_BAR_WORDS 3456
#define XB_SPIN_CAP (1u << 18)
__device__ __forceinline__ unsigned xb_ld(unsigned* p)              { return __hip_atomic_load(p, __ATOMIC_RELAXED, __HIP_MEMORY_SCOPE_AGENT); }
__device__ __forceinline__ unsigned xb_add(unsigned* p, unsigned v) { return __hip_atomic_fetch_add(p, v, __ATOMIC_RELAXED, __HIP_MEMORY_SCOPE_AGENT); }
__device__ __forceinline__ unsigned xb_xcc_id() { return (unsigned)__builtin_amdgcn_s_getreg((3 << 11) | 20) & 0xFu; }
#define XB_SPIN(cond, bar) do { unsigned _sp = 0; while (cond) { __builtin_amdgcn_s_sleep(1); \
    if ((++_sp & 255u) == 0u) { if (xb_ld(&(bar)[XB_TMO])) break; if (_sp > XB_SPIN_CAP) { atomicAdd(&(bar)[XB_TMO], 1u); break; } } } } while (0)
struct XcdBarrier { unsigned* bar; unsigned x; volatile LAS unsigned* st; };
__device__ __forceinline__ XcdBarrier xcd_barrier_post(unsigned* bar, volatile LAS unsigned* st) {
    XcdBarrier b; b.bar = bar; b.x = xb_xcc_id(); b.st = st;
    if (threadIdx.x == 0) (void)xb_add(&bar[XB_XCNT(b.x)], 1u);
    return b;
}
__device__ __forceinline__ void xcd_barrier_complete(unsigned* bar, unsigned x, unsigned& nloc, unsigned& nx) {
    const unsigned G = gridDim.x * gridDim.y * gridDim.z;
    unsigned sum, cnt, mine, sp = 0u;
    for (;;) {
        sum = 0u; cnt = 0u; mine = 0u;
#pragma unroll
        for (unsigned j = 0; j < 16; ++j) { const unsigned c = xb_ld(&bar[XB_XCNT(j)]); sum += c; cnt += (c > 0u) ? 1u : 0u; mine = (j == x) ? c : mine; }
        if (sum == G) break;
        __builtin_amdgcn_s_sleep(1);
        if ((++sp & 255u) == 0u) { if (xb_ld(&bar[XB_TMO])) break; if (sp > XB_SPIN_CAP) { atomicAdd(&bar[XB_TMO], 1u); break; } }
    }
    nloc = mine > 0u ? mine : 1u; nx = cnt > 0u ? cnt : 1u;
}
__device__ __forceinline__ void xcd_barrier(const XcdBarrier& b) {
    asm volatile("s_waitcnt vmcnt(0)" ::: "memory");
    __syncthreads();
    if (threadIdx.x == 0) {
        unsigned* bar = b.bar;
        __builtin_amdgcn_s_waitcnt(0);
        unsigned nloc = b.st[0], nx = b.st[1];
        if (nloc == 0u) { xcd_barrier_complete(bar, b.x, nloc, nx); b.st[0] = nloc; b.st[1] = nx; }
        const unsigned old = xb_add(&bar[XB_XSUB(b.x)], 1u);
        const unsigned gen = old / nloc;
        if (old + 1u == (gen + 1u) * nloc) {
            __builtin_amdgcn_fence(__ATOMIC_RELEASE, "agent");
            asm volatile("s_waitcnt vmcnt(0)" ::: "memory");
            const unsigned og = xb_add(&bar[XB_TOP], 1u);
            const unsigned tg = og / nx;
            if (og + 1u == (tg + 1u) * nx) xb_add(&bar[XB_TOPGEN], 1u);
            else XB_SPIN(xb_ld(&bar[XB_TOPGEN]) == tg, bar);
            __builtin_amdgcn_fence(__ATOMIC_ACQUIRE, "agent");
            xb_add(&bar[XB_XGEN(b.x)], 1u);
            asm volatile("s_waitcnt vmcnt(0)" ::: "memory");
        } else {
            XB_SPIN(xb_ld(&bar[XB_XGEN(b.x)]) == gen, bar);
            __builtin_amdgcn_fence(__ATOMIC_ACQUIRE, "agent");
            asm volatile("s_waitcnt vmcnt(0)" ::: "memory");
        }
    }
    __syncthreads();
}

struct Args { const float* in[39]; const int* pos; float* out; unsigned char* ws; };
struct Frame {
    LAS unsigned char* lds;
    int tid, lane, wave, vcu, G, gw, ngw;
};

__device__ __forceinline__ void tr_item(const float* W, int N, int k0, int n0, bf16* dst, int ldk, LAS float* scr, int lane) {
#pragma unroll 8
    for (int i = 0; i < 32; ++i) { const int kk = 2 * i + (lane >> 5); scr[kk * 33 + (lane & 31)] = W[(size_t)(k0 + kk) * N + n0 + (lane & 31)]; }
    LDS_WAIT(); CBAR();
    const int c = lane & 7;
#pragma unroll
    for (int j = 0; j < 4; ++j) { const int n = (lane >> 3) + 8 * j; const LAS float* s = scr + (8 * c) * 33 + n;
        v4u o; o.x = pk2(s[0 * 33], s[1 * 33]); o.y = pk2(s[2 * 33], s[3 * 33]); o.z = pk2(s[4 * 33], s[5 * 33]); o.w = pk2(s[6 * 33], s[7 * 33]);
        *(v4u*)(dst + (size_t)n * ldk + k0 + 8 * c) = o; }
    LDS_WAIT(); CBAR();
}
__device__ __forceinline__ void tr_plain(const float* W, int K, int N, bf16* WT, int item, LAS float* scr, int lane) {
    const int nblk = N / 32, kb = item / nblk, nb = item % nblk;
    tr_item(W, N, 64 * kb, 32 * nb, WT + (size_t)(32 * nb) * K, K, scr, lane);
}
__device__ __forceinline__ void conv_moe(const Frame& F, const Args& a, int layer, LAS float* scr) {
    bf16* W13T = (bf16*)(a.ws + WS_W13); bf16* W2T = (bf16*)(a.ws + WS_W2);
    for (int it = F.gw; it < 3 * 8192; it += F.ngw) {
        const int type = it >> 13, r = it & 8191, e = r >> 7, q = r & 127;
        if (type < 2) {
            const float* W = a.in[type == 0 ? 36 : 37] + (size_t)(layer * 64 + e) * 1024 * 256;
            const int kb = q >> 3, nb = q & 7, n0 = 32 * nb;
            const int drow = e * 512 + (n0 >> 7) * 256 + (type == 1 ? 128 : 0) + (n0 & 127);
            tr_item(W, 256, 64 * kb, n0, W13T + (size_t)drow * 1024, 1024, scr, F.lane);
        } else {
            const float* W = a.in[38] + (size_t)(layer * 64 + e) * 256 * 1024;
            const int kb = q >> 5, nb = q & 31, n0 = 32 * nb;
            tr_item(W, 1024, 64 * kb, n0, W2T + (size_t)(e * 1024 + n0) * 256, 256, scr, F.lane);
        }
    }
}
__device__ __forceinline__ void norm_row(const f32x4 (&v)[4], const f32x4 (&g)[4], bf16* orow, int lane) {
    float s = 0.f;
#pragma unroll
    for (int j = 0; j < 4; ++j) s += (v[j].x * v[j].x + v[j].y * v[j].y) + (v[j].z * v[j].z + v[j].w * v[j].w);
    const float rs = rsqrtf(wave_sum(s) * (1.f / DM) + RMS_EPS);
    v2u* o8 = (v2u*)orow + lane;
#pragma unroll
    for (int j = 0; j < 4; ++j) { v2u w; w.x = pk2(v[j].x * rs * g[j].x, v[j].y * rs * g[j].y); w.y = pk2(v[j].z * rs * g[j].z, v[j].w * rs * g[j].w); o8[64 * j] = w; }
}

__device__ __forceinline__ void p0_prologue(const Frame& F, const Args& a) {
    LAS float* scr = (LAS float*)(F.lds + F.wave * WSCR);
    unsigned char* ws = a.ws;
    for (int it = F.gw; it < 2816; it += F.ngw) {
        int r = it;
        if (r < 768) { tr_plain(a.in[3], 1024, 1536, (bf16*)(ws + WS_WIN), r, scr, F.lane); continue; } r -= 768;
        if (r < 128) { tr_plain(a.in[12], 512, 512, (bf16*)(ws + WS_GLU), r, scr, F.lane); continue; } r -= 128;
        if (r < 512) { tr_plain(a.in[21], 1024, 1024, (bf16*)(ws + WS_WOUT), r, scr, F.lane); continue; } r -= 512;
        if (r < 352) { tr_plain(a.in[23], 1024, 704, (bf16*)(ws + WS_MIN), r, scr, F.lane); continue; } r -= 352;
        if (r < 288) { tr_plain(a.in[26], 384, 1536, (bf16*)(ws + WS_UQ), r, scr, F.lane); continue; } r -= 288;
        if (r < 256) {
            const int kb = r / 64, nb = r % 64, n0 = 32 * nb, h = n0 >> 8, rr = n0 & 255;
            bf16* dst = (rr < 128) ? (bf16*)(ws + WS_UK) + (size_t)(h * 128 + rr) * 256 : (bf16*)(ws + WS_UV) + (size_t)(h * 128 + rr - 128) * 256;
            tr_item(a.in[27], 2048, 64 * kb, n0, dst, 256, scr, F.lane); continue; } r -= 256;
        tr_plain(a.in[30], 1024, 1024, (bf16*)(ws + WS_WO), r, scr, F.lane);
    }
    { v4u* z = (v4u*)((bf16*)(ws + WS_MIN) + (size_t)704 * 1024); const int n16 = 64 * 1024 * 2 / 16;
      for (int i = F.gw * 64 + F.lane; i < n16; i += F.ngw * 64) z[i] = (v4u){0u, 0u, 0u, 0u}; }
    { bf16* wr = (bf16*)(ws + WS_WR);
      for (int i = F.gw * 64 + F.lane; i < 2 * 96 * 1024; i += F.ngw * 64) {
          const int layer = i / (96 * 1024), rem = i % (96 * 1024), r = rem >> 10, k = rem & 1023;
          float v = 0.f;
          if (r < 8) v = a.in[32][(size_t)(layer * 1024 + k) * 8 + r];
          else if (r < 72) v = a.in[34][(size_t)(layer * 1024 + k) * 64 + (r - 8)];
          wr[i] = (bf16)f2bf(v); } }
    { v4u* waf = (v4u*)(ws + AR_WAF);
      for (int i = F.gw * 64 + F.lane; i < 8192; i += F.ngw * 64) {
          const int ln = i & 63, sx = (i >> 6) & 3, blk = (i >> 8) & 1, gate = (i >> 9) & 1, n = i >> 10;
          const float* W = a.in[gate ? 18 : 16] + (size_t)n * 64 * 64; const int d = (ln & 31) + 32 * blk, c0 = 16 * sx + 8 * (ln >> 5);
          float v[8];
#pragma unroll
          for (int j = 0; j < 8; ++j) v[j] = W[(c0 + j) * 64 + d];
          v4u o; o.x = pk2(v[0], v[1]); o.y = pk2(v[2], v[3]); o.z = pk2(v[4], v[5]); o.w = pk2(v[6], v[7]); waf[i] = o; } }
    conv_moe(F, a, 0, scr);
    { const float* x = a.in[0]; const float* gn = a.in[2]; bf16* XN = (bf16*)(ws + WS_XN);
      f32x4 g[4];
#pragma unroll
      for (int j = 0; j < 4; ++j) g[j] = *((const f32x4*)gn + F.lane + 64 * j);
      for (int m = F.gw; m < NT; m += F.ngw) { f32x4 v[4]; const f32x4* xr = (const f32x4*)(x + (size_t)m * DM) + F.lane;
#pragma unroll
          for (int j = 0; j < 4; ++j) v[j] = xr[64 * j];
          norm_row(v, g, XN + (size_t)m * DM, F.lane); } }
}

__device__ __forceinline__ void cmul_acc(float& sr, float& si, float ar, float ai, float br, float bi) { const float nr = ar * sr - ai * si + br, ni = ar * si + ai * sr + bi; sr = nr; si = ni; }
__device__ __forceinline__ void s5_unit(const Frame& F, const Args& a, int b, int g) {
    const int lane = F.lane, w = F.wave, r32 = lane & 31, hh = lane >> 5;
    LAS float* BU = (LAS float*)(F.lds + w * WSCR);
    LAS float* EX = (LAS float*)(F.lds + EX_OFF);
    const bf16* PROJ = (const bf16*)(a.ws + AR_PROJ); bf16* YAPRE = (bf16*)(a.ws + AR_YAPRE);
    const float* lam_re = a.in[4] + g * 64; const float* lam_im = a.in[5] + g * 64; const float dt = __expf(a.in[6][g]);
    const float* b_re = a.in[7] + (size_t)g * 64 * 16; const float* b_im = a.in[8] + (size_t)g * 64 * 16;
    const float* c_re = a.in[9] + (size_t)g * 16 * 64; const float* c_im = a.in[10] + (size_t)g * 16 * 64; const float* dvec = a.in[11] + g * 16;
    float lbr, lbi;
    { const float lr = fminf(lam_re[lane], -1e-4f), li = lam_im[lane]; const float mag = expf(lr * dt); lbr = mag * cosf(li * dt); lbi = mag * sinf(li * dt); }
    bf16x8 af[4];
#pragma unroll
    for (int pb = 0; pb < 2; ++pb) {
        const int p = r32 + 32 * pb;
        const float lr = fminf(lam_re[p], -1e-4f), li = lam_im[p]; const float mag = expf(lr * dt); const float pr = mag * cosf(li * dt), pi = mag * sinf(li * dt);
        const float den = lr * lr + li * li, nr = pr - 1.0f; const float fr_ = (nr * lr + pi * li) / den, fi_ = (pi * lr - nr * li) / den;
        const f32x4 br0 = *(const f32x4*)(b_re + p * 16 + 8 * hh), br1 = *(const f32x4*)(b_re + p * 16 + 8 * hh + 4);
        const f32x4 bi0 = *(const f32x4*)(b_im + p * 16 + 8 * hh), bi1 = *(const f32x4*)(b_im + p * 16 + 8 * hh + 4);
        v4u wre, wim;
        wre.x = pk2(fr_ * br0.x - fi_ * bi0.x, fr_ * br0.y - fi_ * bi0.y); wre.y = pk2(fr_ * br0.z - fi_ * bi0.z, fr_ * br0.w - fi_ * bi0.w);
        wre.z = pk2(fr_ * br1.x - fi_ * bi1.x, fr_ * br1.y - fi_ * bi1.y); wre.w = pk2(fr_ * br1.z - fi_ * bi1.z, fr_ * br1.w - fi_ * bi1.w);
        wim.x = pk2(fr_ * bi0.x + fi_ * br0.x, fr_ * bi0.y + fi_ * br0.y); wim.y = pk2(fr_ * bi0.z + fi_ * br0.z, fr_ * bi0.w + fi_ * br0.w);
        wim.z = pk2(fr_ * bi1.x + fi_ * br1.x, fr_ * bi1.y + fi_ * br1.y); wim.w = pk2(fr_ * bi1.z + fi_ * br1.z, fr_ * bi1.w + fi_ * br1.w);
        af[pb] = __builtin_bit_cast(bf16x8, wre); af[2 + pb] = __builtin_bit_cast(bf16x8, wim);
    }
    const int h16 = lane & 15, kq = lane >> 4;
    bf16x8 cf[4];
#pragma unroll
    for (int ks = 0; ks < 4; ++ks) {
        const int k = 32 * ks + 8 * kq; const float* src = (k < 64) ? (c_re + h16 * 64 + k) : (c_im + h16 * 64 + (k - 64)); const float sg = (k < 64) ? 1.f : -1.f;
        const f32x4 c0 = *(const f32x4*)src, c1 = *(const f32x4*)(src + 4);
        v4u wv; wv.x = pk2(sg * c0.x, sg * c0.y); wv.y = pk2(sg * c0.z, sg * c0.w); wv.z = pk2(sg * c1.x, sg * c1.y); wv.w = pk2(sg * c1.z, sg * c1.w);
        cf[ks] = __builtin_bit_cast(bf16x8, wv);
    }
    const f32x4 dv = *(const f32x4*)(dvec + 4 * kq);
    const size_t tbase = (size_t)b * SL + (size_t)w * 256;
    float sr = 0.f, si = 0.f;
    bf16x8 ufr[8]; v2u uur[8][2];
#pragma unroll
    for (int sb = 0; sb < 8; ++sb) ufr[sb] = *(const bf16x8*)(PROJ + (tbase + sb * 32 + r32) * 1536 + g * 16 + 8 * hh);
#pragma unroll 1
    for (int pass = 0; pass < 2; ++pass) {
        if (pass == 1) {
#pragma unroll
            for (int sb = 0; sb < 8; ++sb) { uur[sb][0] = *(const v2u*)(PROJ + (tbase + sb * 32 + h16) * 1536 + g * 16 + 4 * kq); uur[sb][1] = *(const v2u*)(PROJ + (tbase + sb * 32 + 16 + h16) * 1536 + g * 16 + 4 * kq); }
            EX[w * 128 + lane] = sr; EX[w * 128 + 64 + lane] = si;
            LDS_WAIT(); __syncthreads();
            float pr = lbr, pi = lbi;
#pragma unroll
            for (int q = 0; q < 8; ++q) { const float nr = pr * pr - pi * pi, ni = 2.f * pr * pi; pr = nr; pi = ni; }
            sr = 0.f; si = 0.f;
            for (int wp = 0; wp < w; ++wp) cmul_acc(sr, si, pr, pi, EX[wp * 128 + lane], EX[wp * 128 + 64 + lane]);
        }
#pragma unroll
        for (int sb = 0; sb < 8; ++sb) {
            const size_t t0 = tbase + sb * 32;
            const bf16x8 uf = ufr[sb];
#pragma unroll
            for (int blk = 0; blk < 4; ++blk) {
                f32x16 acc = {};
                acc = __builtin_amdgcn_mfma_f32_32x32x16_bf16(af[blk], uf, acc, 0, 0, 0);
#pragma unroll
                for (int q = 0; q < 4; ++q) *(LAS f32x4*)(BU + r32 * 132 + 32 * blk + 8 * q + 4 * hh) = (f32x4){acc[4 * q], acc[4 * q + 1], acc[4 * q + 2], acc[4 * q + 3]};
            }
            LDS_WAIT(); CBAR();
            if (pass == 0) {
#pragma unroll 8
                for (int t = 0; t < 32; ++t) cmul_acc(sr, si, lbr, lbi, BU[t * 132 + lane], BU[t * 132 + 64 + lane]);
            } else {
#pragma unroll 8
                for (int t = 0; t < 32; ++t) { cmul_acc(sr, si, lbr, lbi, BU[t * 132 + lane], BU[t * 132 + 64 + lane]); BU[t * 132 + lane] = sr; BU[t * 132 + 64 + lane] = si; }
                LDS_WAIT(); CBAR();
#pragma unroll
                for (int tb = 0; tb < 2; ++tb) {
                    f32x4 y = {0.f, 0.f, 0.f, 0.f};
#pragma unroll
                    for (int ks = 0; ks < 4; ++ks) {
                        const LAS float* sp = BU + (16 * tb + h16) * 132 + 32 * ks + 8 * kq;
                        const f32x4 s0 = *(const LAS f32x4*)sp, s1 = *(const LAS f32x4*)(sp + 4);
                        v4u wv; wv.x = pk2(s0.x, s0.y); wv.y = pk2(s0.z, s0.w); wv.z = pk2(s1.x, s1.y); wv.w = pk2(s1.z, s1.w);
                        y = __builtin_amdgcn_mfma_f32_16x16x32_bf16(cf[ks], __builtin_bit_cast(bf16x8, wv), y, 0, 0, 0);
                    }
                    const size_t t = t0 + 16 * tb + h16;
                    const v2u uu = uur[sb][tb];
                    const float y0 = gelu_tanh(y[0] + dv.x * bflo(uu.x)), y1 = gelu_tanh(y[1] + dv.y * bfhi(uu.x)), y2 = gelu_tanh(y[2] + dv.z * bflo(uu.y)), y3 = gelu_tanh(y[3] + dv.w * bfhi(uu.y));
                    v2u o; o.x = pk2(y0, y1); o.y = pk2(y2, y3);
                    *(v2u*)(YAPRE + t * 512 + g * 16 + 4 * kq) = o;
                }
                LDS_WAIT(); CBAR();
            }
        }
    }
    __syncthreads();
}
template <int PASS>
__device__ __forceinline__ void lru_chunk(const Frame& F, const Args& a, int b, int n, int q) {
    const int lane = F.lane, w = F.wave, r32 = lane & 31, hh = lane >> 5, ch = n * 64 + lane, ci = 8 * q + w;
    LAS unsigned char* scrb = F.lds + w * WSCR;
    LAS bf16* XF = (LAS bf16*)scrb;
    LAS float* GA = (LAS float*)scrb;
    LAS float* GI = (LAS float*)(scrb + 32 * 68 * 4);
    const bf16* PROJ = (const bf16*)(a.ws + AR_PROJ); bf16* YCAT = (bf16*)(a.ws + AR_YCAT);
    float* CA = (float*)(a.ws + AR_LRUC) + (size_t)((b * 8 + n) * 32) * 64; float* CH = CA + 8 * 8 * 32 * 64;
    const float L2E = 1.4426950408889634f;
    const float cw0 = a.in[14][0 * 512 + ch], cw1 = a.in[14][1 * 512 + ch], cw2 = a.in[14][2 * 512 + ch], cw3 = a.in[14][3 * 512 + ch], cb = a.in[15][ch];
    const float ba = -L2E * a.in[17][ch], bi = -L2E * a.in[19][ch];
    const float lsl8 = -8.0f * L2E * log1pf(expf(-a.in[20][ch]));
    bf16x8 fa[2][4], fi[2][4];
    { const bf16x8* wf = (const bf16x8*)(a.ws + AR_WAF) + (size_t)n * 2 * 2 * 4 * 64 + lane;
#pragma unroll
      for (int blk = 0; blk < 2; ++blk)
#pragma unroll
          for (int s = 0; s < 4; ++s) { fa[blk][s] = wf[((0 * 2 + blk) * 4 + s) * 64]; fi[blk][s] = wf[((1 * 2 + blk) * 4 + s) * 64]; } }
    const int l0 = ci * 64; const size_t tbase = (size_t)b * SL + l0;
    float hst = 0.f, aprod = 1.f;
    if (PASS == 1) {
        for (int cp = 0; cp < ci; ++cp) hst = CA[cp * 64 + lane] * hst + CH[cp * 64 + lane];
    }
    float xm3 = 0.f, xm2 = 0.f, xm1 = 0.f;
    if (l0 > 0) { xm3 = bf2f(PROJ[(tbase - 3) * 1536 + 512 + ch]); xm2 = bf2f(PROJ[(tbase - 2) * 1536 + 512 + ch]); xm1 = bf2f(PROJ[(tbase - 1) * 1536 + 512 + ch]); }
#pragma unroll 1
    for (int sb = 0; sb < 2; ++sb) {
        const size_t t0 = tbase + sb * 32;
        float xf[32]; unsigned short glr[32];
#pragma unroll
        for (int t = 0; t < 32; ++t) xf[t] = bf2f(PROJ[(t0 + t) * 1536 + 512 + ch]);
#pragma unroll
        for (int t = 0; t < 32; ++t) { const float xc = xf[t];
            xf[t] = cw0 * xm3 + cw1 * xm2 + cw2 * xm1 + cw3 * xc + cb; xm3 = xm2; xm2 = xm1; xm1 = xc;
            XF[t * 72 + lane] = (bf16)f2bf(xf[t]); }
        LDS_WAIT(); CBAR();
        bf16x8 xb[4];
#pragma unroll
        for (int s = 0; s < 4; ++s) xb[s] = *(const LAS bf16x8*)(XF + r32 * 72 + 16 * s + 8 * hh);
        LDS_WAIT(); CBAR();
#pragma unroll
        for (int blk = 0; blk < 2; ++blk) {
            f32x16 ga = {}, gi = {};
#pragma unroll
            for (int s = 0; s < 4; ++s) { ga = __builtin_amdgcn_mfma_f32_32x32x16_bf16(fa[blk][s], xb[s], ga, 0, 0, 0); gi = __builtin_amdgcn_mfma_f32_32x32x16_bf16(fi[blk][s], xb[s], gi, 0, 0, 0); }
#pragma unroll
            for (int qq = 0; qq < 4; ++qq) { *(LAS f32x4*)(GA + r32 * 68 + 32 * blk + 8 * qq + 4 * hh) = (f32x4){ga[4 * qq], ga[4 * qq + 1], ga[4 * qq + 2], ga[4 * qq + 3]};
                                             *(LAS f32x4*)(GI + r32 * 68 + 32 * blk + 8 * qq + 4 * hh) = (f32x4){gi[4 * qq], gi[4 * qq + 1], gi[4 * qq + 2], gi[4 * qq + 3]}; }
        }
        if (PASS == 1) {
#pragma unroll
            for (int t = 0; t < 32; ++t) glr[t] = PROJ[(t0 + t) * 1536 + 1024 + ch]; }
        LDS_WAIT(); CBAR();
#pragma unroll
        for (int t = 0; t < 32; ++t) {
            const float ra = __builtin_amdgcn_rcpf(1.0f + __builtin_amdgcn_exp2f(fmaf(GA[t * 68 + lane], -L2E, ba)));
            const float ri = __builtin_amdgcn_rcpf(1.0f + __builtin_amdgcn_exp2f(fmaf(GI[t * 68 + lane], -L2E, bi)));
            const float av = __builtin_amdgcn_exp2f(ra * lsl8);
            const float bv = __builtin_amdgcn_sqrtf(fmaxf(fmaf(-av, av, 1.0f), 0.f)) * (ri * xf[t]);
            hst = fmaf(av, hst, bv);
            if (PASS == 0) aprod *= av;
            else YCAT[(t0 + t) * 1024 + 512 + ch] = (bf16)f2bf(hst * gelu_tanh(bf2f(glr[t])));
        }
        LDS_WAIT(); CBAR();
    }
    if (PASS == 0) { CA[ci * 64 + lane] = aprod; CH[ci * 64 + lane] = hst; }
}
__device__ __forceinline__ void mixers_a(const Frame& F, const Args& a) {
    if (PH(3)) for (int u = F.vcu; u < 256; u += F.G) lru_chunk<0>(F, a, u >> 5, (u >> 2) & 7, u & 3);
    CBAR(); __syncthreads(); CBAR();
    if (PH(2)) for (int u = F.vcu; u < 256; u += F.G) s5_unit(F, a, u >> 5, u & 31);
}
__device__ __forceinline__ void mixers_b(const Frame& F, const Args& a) {
    if (PH(18)) for (int u = F.vcu; u < 256; u += F.G) lru_chunk<1>(F, a, u >> 5, (u >> 2) & 7, u & 3);
    CBAR(); __syncthreads(); CBAR();
}

__device__ __forceinline__ void norm_phase(const Frame& F, const float* xin, const float* gain, bf16* XN) {
    f32x4 g[4];
#pragma unroll
    for (int j = 0; j < 4; ++j) g[j] = *((const f32x4*)gain + F.lane + 64 * j);
    for (int m = F.gw; m < NT; m += F.ngw) { f32x4 v[4]; const f32x4* xr = (const f32x4*)(xin + (size_t)m * DM) + F.lane;
#pragma unroll
        for (int j = 0; j < 4; ++j) v[j] = xr[64 * j];
        norm_row(v, g, XN + (size_t)m * DM, F.lane); }
}
__device__ __forceinline__ void router_phase(const Frame& F, const Args& a, int layer) {
    const int lane = F.lane, r32 = lane & 31, hh = lane >> 5;
    LAS float* LG = (LAS float*)(F.lds + F.wave * WSCR);
    const bf16* XN = (const bf16*)(a.ws + WS_XN); const bf16* WrT = (const bf16*)(a.ws + WS_WR) + (size_t)layer * 96 * 1024;
    const float* bg = a.in[33] + layer * 8; const float* be = a.in[35] + layer * 64;
    unsigned* cnt = (unsigned*)(a.ws + WS_CTL) + CW_CNT + layer * 2048;
    int* TE = (int*)(a.ws + AR_TOK); float* TG = (float*)(a.ws + AR_TOK + 128 * 1024); int* TP = (int*)(a.ws + AR_TOK + 256 * 1024);
    for (int u = F.gw; u < NT / 32; u += F.ngw) {
        const size_t t0 = (size_t)u * 32;
        f32x16 acc[3] = {};
        const bf16* xp = XN + (t0 + r32) * DM + 8 * hh; const bf16* wp = WrT + (size_t)r32 * DM + 8 * hh;
#pragma unroll 4
        for (int s = 0; s < 64; ++s) {
            const bf16x8 xb = *(const bf16x8*)(xp + 16 * s);
#pragma unroll
            for (int blk = 0; blk < 3; ++blk) { const bf16x8 wa = *(const bf16x8*)(wp + (size_t)blk * 32 * DM + 16 * s); acc[blk] = __builtin_amdgcn_mfma_f32_32x32x16_bf16(wa, xb, acc[blk], 0, 0, 0); }
        }
#pragma unroll
        for (int blk = 0; blk < 3; ++blk)
#pragma unroll
            for (int q = 0; q < 4; ++q) *(LAS f32x4*)(LG + r32 * 100 + 32 * blk + 8 * q + 4 * hh) = (f32x4){acc[blk][4 * q], acc[blk][4 * q + 1], acc[blk][4 * q + 2], acc[blk][4 * q + 3]};
        LDS_WAIT(); CBAR();
        if (lane < 32) {
            const LAS float* row = LG + lane * 100;
            float gl[8]; float gmax = -3.0e38f; int gsel = 0;
#pragma unroll
            for (int i = 0; i < 8; ++i) { gl[i] = row[i] + bg[i]; if (gl[i] > gmax) { gmax = gl[i]; gsel = i; } }
            float gs = 0.f;
#pragma unroll
            for (int i = 0; i < 8; ++i) gs += __expf(gl[i] - gmax);
            const float pg = 1.0f / gs;
            float v1 = -3.0e38f, v2 = -3.0e38f; int i1 = 0, i2 = 0;
#pragma unroll
            for (int i = 0; i < 8; ++i) { const float v = row[8 + gsel * 8 + i] + be[gsel * 8 + i];
                if (v > v1) { v2 = v1; i2 = i1; v1 = v; i1 = i; } else if (v > v2) { v2 = v; i2 = i; } }
            const float e2 = __expf(v2 - v1), inv = 1.0f / (1.0f + e2);
            const int ea = gsel * 8 + i1, eb = gsel * 8 + i2;
            const size_t t = t0 + lane;
            const unsigned pa = atomicAdd(cnt + ea * 16, 1u), pb = atomicAdd(cnt + eb * 16, 1u);
            TE[2 * t] = ea; TE[2 * t + 1] = eb; TG[2 * t] = pg * inv; TG[2 * t + 1] = pg * e2 * inv; TP[2 * t] = (int)pa; TP[2 * t + 1] = (int)pb;
        }
        LDS_WAIT(); CBAR();
    }
}
__device__ __forceinline__ void scatter_phase(const Frame& F, const Args& a, int layer) {
    LAS int* PADS = (LAS int*)(F.lds + TAB_OFF);
    LAS int* TILE_E = PADS + 64;
    LAS int* NRT = TILE_E + MAX_RT;
    const unsigned* cnt = (const unsigned*)(a.ws + WS_CTL) + CW_CNT + layer * 2048;
    if (F.tid == 0) {
        int acc = 0;
        for (int e = 0; e < 64; ++e) { const int c = (int)__hip_atomic_load(cnt + e * 16, RLX_AGENT); const int nt = (c + 255) >> 8; PADS[e] = acc * 256; for (int j = 0; j < nt; ++j) TILE_E[acc + j] = e; acc += nt; }
        NRT[0] = acc;
    }
    __syncthreads();
    const bf16* XN = (const bf16*)(a.ws + WS_XN); bf16* XD = (bf16*)(a.ws + AR_XDISP);
    const int* TE = (const int*)(a.ws + AR_TOK); const int* TP = (const int*)(a.ws + AR_TOK + 256 * 1024); int* TD = (int*)(a.ws + AR_TOK + 384 * 1024);
    for (int t = F.gw; t < NT; t += F.ngw) {
        const int d0 = PADS[TE[2 * t]] + TP[2 * t], d1 = PADS[TE[2 * t + 1]] + TP[2 * t + 1];
        const v4u* src = (const v4u*)(XN + (size_t)t * DM) + F.lane; const v4u x0 = src[0], x1 = src[64];
        v4u* p0 = (v4u*)(XD + (size_t)d0 * DM) + F.lane; p0[0] = x0; p0[64] = x1;
        v4u* p1 = (v4u*)(XD + (size_t)d1 * DM) + F.lane; p1[0] = x0; p1[64] = x1;
        if (F.lane == 0) { TD[2 * t] = d0; TD[2 * t + 1] = d1; }
    }
}
template <bool NORM>
__device__ __forceinline__ void combine_phase(const Frame& F, const Args& a, const float* xin, float* xout, const float* gain, bf16* XN) {
    const bf16* YD = (const bf16*)(a.ws + AR_YDISP); const float* TG = (const float*)(a.ws + AR_TOK + 128 * 1024); const int* TD = (const int*)(a.ws + AR_TOK + 384 * 1024);
    f32x4 g[4];
    if (NORM) {
#pragma unroll
        for (int j = 0; j < 4; ++j) g[j] = *((const f32x4*)gain + F.lane + 64 * j); }
    for (int t = F.gw; t < NT; t += F.ngw) {
        const int d0 = TD[2 * t], d1 = TD[2 * t + 1]; const float g0 = TG[2 * t], g1 = TG[2 * t + 1];
        const f32x4* xr = (const f32x4*)(xin + (size_t)t * DM) + F.lane; const v2u* y0 = (const v2u*)(YD + (size_t)d0 * DM) + F.lane; const v2u* y1 = (const v2u*)(YD + (size_t)d1 * DM) + F.lane;
        f32x4 v[4];
#pragma unroll
        for (int j = 0; j < 4; ++j) { const f32x4 x = xr[64 * j]; const v2u a0 = y0[64 * j], a1 = y1[64 * j];
            v[j].x = x.x + g0 * bflo(a0.x) + g1 * bflo(a1.x); v[j].y = x.y + g0 * bfhi(a0.x) + g1 * bfhi(a1.x);
            v[j].z = x.z + g0 * bflo(a0.y) + g1 * bflo(a1.y); v[j].w = x.w + g0 * bfhi(a0.y) + g1 * bfhi(a1.y); }
        f32x4* xo = (f32x4*)(xout + (size_t)t * DM) + F.lane;
#pragma unroll
        for (int j = 0; j < 4; ++j) xo[64 * j] = v[j];
        if (NORM) norm_row(v, g, XN + (size_t)t * DM, F.lane);
    }
}

__device__ const float INV_FREQ[32] = {
    1.0f, 0.7498942093324559f, 0.5623413251903491f, 0.4216965034285822f, 0.31622776601683794f, 0.23713737056616552f, 0.1778279410038923f, 0.1333521432163324f,
    0.1f, 0.07498942093324558f, 0.05623413251903491f, 0.04216965034285822f, 0.031622776601683794f, 0.023713737056616554f, 0.01778279410038923f, 0.01333521432163324f,
    0.01f, 0.007498942093324558f, 0.005623413251903491f, 0.004216965034285822f, 0.0031622776601683794f, 0.0023713737056616554f, 0.001778279410038923f, 0.001333521432163324f,
    0.001f, 0.0007498942093324559f, 0.0005623413251903491f, 0.0004216965034285822f, 0.00031622776601683794f, 0.00023713737056616554f, 0.0001778279410038923f, 0.0001333521432163324f };
__device__ __forceinline__ void mla_lora_norm_phase(const Frame& F, const Args& a) {
    const bf16* CQR = (const bf16*)(a.ws + AR_CQR); const bf16* CKVR = (const bf16*)(a.ws + AR_CKVR);
    bf16* CQ = (bf16*)(a.ws + AR_CQ); bf16* CKV = (bf16*)(a.ws + AR_CKV); float* COS = (float*)(a.ws + AR_COS); float* SIN = (float*)(a.ws + AR_SIN);
    const int lane = F.lane;
    const bool isq = lane < 48;
    const bool iskv = lane < 32;
    float gq[8], gk[8];
#pragma unroll
    for (int j = 0; j < 8; ++j) { gq[j] = isq ? a.in[24][lane * 8 + j] : 0.f; gk[j] = iskv ? a.in[25][lane * 8 + j] : 0.f; }
    for (int t0 = F.gw * 2; t0 < NT; t0 += F.ngw * 2) {
        v4u rq[2], rk[2];
#pragma unroll
        for (int u = 0; u < 2; ++u) { const size_t t = t0 + u;
            rq[u] = isq ? *(const v4u*)(CQR + t * 384 + lane * 8) : (v4u){0u, 0u, 0u, 0u};
            rk[u] = iskv ? *(const v4u*)(CKVR + t * 256 + lane * 8) : (v4u){0u, 0u, 0u, 0u}; }
#pragma unroll
        for (int u = 0; u < 2; ++u) { const size_t t = t0 + u;
            float q[8] = {bflo(rq[u].x), bfhi(rq[u].x), bflo(rq[u].y), bfhi(rq[u].y), bflo(rq[u].z), bfhi(rq[u].z), bflo(rq[u].w), bfhi(rq[u].w)};
            float k[8] = {bflo(rk[u].x), bfhi(rk[u].x), bflo(rk[u].y), bfhi(rk[u].y), bflo(rk[u].z), bfhi(rk[u].z), bflo(rk[u].w), bfhi(rk[u].w)};
            float sq = 0.f, sk = 0.f;
#pragma unroll
            for (int j = 0; j < 8; ++j) { sq += q[j] * q[j]; sk += k[j] * k[j]; }
            const float nq = rsqrtf(wave_sum(sq) * (1.f / 384.f) + RMS_EPS), nk = rsqrtf(wave_sum(sk) * (1.f / 256.f) + RMS_EPS);
            if (isq) { v4u o; o.x = pk2(q[0] * nq * gq[0], q[1] * nq * gq[1]); o.y = pk2(q[2] * nq * gq[2], q[3] * nq * gq[3]); o.z = pk2(q[4] * nq * gq[4], q[5] * nq * gq[5]); o.w = pk2(q[6] * nq * gq[6], q[7] * nq * gq[7]);
                *(v4u*)(CQ + t * 384 + lane * 8) = o; }
            if (iskv) { v4u o; o.x = pk2(k[0] * nk * gk[0], k[1] * nk * gk[1]); o.y = pk2(k[2] * nk * gk[2], k[3] * nk * gk[3]); o.z = pk2(k[4] * nk * gk[4], k[5] * nk * gk[5]); o.w = pk2(k[6] * nk * gk[6], k[7] * nk * gk[7]);
                *(v4u*)(CKV + t * 256 + lane * 8) = o;
                const float ang = (float)a.pos[t] * INV_FREQ[lane];
                const double tw = 6.283185307179586476925286766559; const double ad = (double)ang; const double nn = __builtin_rint(ad / tw); const float rr = (float)(ad - nn * tw);
                COS[t * 32 + lane] = cosf(rr); SIN[t * 32 + lane] = sinf(rr); }
        }
    }
}
__device__ __forceinline__ void qk_row(const v4u r0, const v4u r1, const v4u r2, const float (&g0)[8], const float (&g1)[8], const float (&g2)[8], const float (&cs)[8], const float (&sn)[8], float sgn, float scale, bf16* dst, int sub) {
    float x0[8] = {bflo(r0.x), bfhi(r0.x), bflo(r0.y), bfhi(r0.y), bflo(r0.z), bfhi(r0.z), bflo(r0.w), bfhi(r0.w)};
    float x1[8] = {bflo(r1.x), bfhi(r1.x), bflo(r1.y), bfhi(r1.y), bflo(r1.z), bfhi(r1.z), bflo(r1.w), bfhi(r1.w)};
    float x2[8] = {bflo(r2.x), bfhi(r2.x), bflo(r2.y), bfhi(r2.y), bflo(r2.z), bfhi(r2.z), bflo(r2.w), bfhi(r2.w)};
    float ss = 0.f;
#pragma unroll
    for (int j = 0; j < 8; ++j) ss += x0[j] * x0[j] + x1[j] * x1[j] + x2[j] * x2[j];
    ss += __shfl_xor(ss, 1); ss += __shfl_xor(ss, 2); ss += __shfl_xor(ss, 4);
    const float rk = rsqrtf(ss * (1.f / 192.f) + RMS_EPS);
    float y2[8];
#pragma unroll
    for (int j = 0; j < 8; ++j) { x0[j] *= rk * g0[j]; x1[j] *= rk * g1[j]; x2[j] *= rk * g2[j]; }
#pragma unroll
    for (int j = 0; j < 8; ++j) { const float pr = __shfl_xor(x2[j], 4); y2[j] = (x2[j] * cs[j] + sgn * pr * sn[j]) * scale; }
    v4u o; o.x = pk2(x0[0] * scale, x0[1] * scale); o.y = pk2(x0[2] * scale, x0[3] * scale); o.z = pk2(x0[4] * scale, x0[5] * scale); o.w = pk2(x0[6] * scale, x0[7] * scale); *(v4u*)(dst + 8 * sub) = o;
    o.x = pk2(x1[0] * scale, x1[1] * scale); o.y = pk2(x1[2] * scale, x1[3] * scale); o.z = pk2(x1[4] * scale, x1[5] * scale); o.w = pk2(x1[6] * scale, x1[7] * scale); *(v4u*)(dst + 64 + 8 * sub) = o;
    o.x = pk2(y2[0], y2[1]); o.y = pk2(y2[2], y2[3]); o.z = pk2(y2[4], y2[5]); o.w = pk2(y2[6], y2[7]); *(v4u*)(dst + 128 + 8 * sub) = o;
}
__device__ __forceinline__ void mla_qk_phase(const Frame& F, const Args& a) {
    const bf16* QRAW = (const bf16*)(a.ws + AR_QRAW); const bf16* KNRAW = (const bf16*)(a.ws + AR_KNRAW); const bf16* KRR = (const bf16*)(a.ws + AR_KRR);
    bf16* QF = (bf16*)(a.ws + AR_QF); bf16* KF = (bf16*)(a.ws + AR_KF); const float* COS = (const float*)(a.ws + AR_COS); const float* SIN = (const float*)(a.ws + AR_SIN);
    const int lane = F.lane, h = lane >> 3, sub = lane & 7;
    float kg0[8], kg1[8], kg2[8], qg0[8], qg1[8], qg2[8];
#pragma unroll
    for (int j = 0; j < 8; ++j) { kg0[j] = a.in[29][8 * sub + j]; kg1[j] = a.in[29][64 + 8 * sub + j]; kg2[j] = a.in[29][128 + 8 * sub + j];
                                  qg0[j] = a.in[28][8 * sub + j]; qg1[j] = a.in[28][64 + 8 * sub + j]; qg2[j] = a.in[28][128 + 8 * sub + j]; }
    const float sgn = (sub < 4) ? -1.f : 1.f; const int ci = (8 * sub) & 31;
    const float QS = 1.4426950408889634f * 0.07216878364870322f;
    for (int t = F.gw; t < NT; t += F.ngw) {
        const int b = t >> 11, l = t & 2047;
        const v4u k0 = *(const v4u*)(KNRAW + (size_t)t * 1024 + h * 128 + 8 * sub), k1 = *(const v4u*)(KNRAW + (size_t)t * 1024 + h * 128 + 64 + 8 * sub), k2 = *(const v4u*)(KRR + (size_t)t * 64 + 8 * sub);
        const v4u q0 = *(const v4u*)(QRAW + (size_t)t * 1536 + h * 192 + 8 * sub), q1 = *(const v4u*)(QRAW + (size_t)t * 1536 + h * 192 + 64 + 8 * sub), q2 = *(const v4u*)(QRAW + (size_t)t * 1536 + h * 192 + 128 + 8 * sub);
        const f32x4 c0 = *(const f32x4*)(COS + (size_t)t * 32 + ci), c1 = *(const f32x4*)(COS + (size_t)t * 32 + ci + 4), s0 = *(const f32x4*)(SIN + (size_t)t * 32 + ci), s1 = *(const f32x4*)(SIN + (size_t)t * 32 + ci + 4);
        const float cs[8] = {c0.x, c0.y, c0.z, c0.w, c1.x, c1.y, c1.z, c1.w}; const float sn[8] = {s0.x, s0.y, s0.z, s0.w, s1.x, s1.y, s1.z, s1.w};
        const size_t orow = ((size_t)(b * 8 + h) * SL + l) * 192;
        qk_row(k0, k1, k2, kg0, kg1, kg2, cs, sn, sgn, 1.0f, KF + orow, sub);
        qk_row(q0, q1, q2, qg0, qg1, qg2, cs, sn, sgn, QS, QF + orow, sub);
    }
}

constexpr int AT_KB = 64 * 400, AT_VB = 128 * 144 + 256, AT_VOFF = 2 * AT_KB;
__device__ __forceinline__ void attn_block(const Frame& F, const Args& a, int b, int h, int qb) {
    const int tid = F.tid, lane = F.lane, w = F.wave, r32 = lane & 31, hh = lane >> 5;
    const bf16* KF = (const bf16*)(a.ws + AR_KF); const bf16* VT = (const bf16*)(a.ws + AR_VT); bf16* O = (bf16*)(a.ws + AR_O);
    LAS unsigned char* lds = F.lds;
    const int q0 = qb * 256, qrow0 = q0 + 32 * w, nt = 4 * (qb + 1);
    const bf16* Kg = KF + (size_t)(b * 8 + h) * SL * 192;
    const bf16* Vg = VT + (size_t)(h * 128) * NT + (size_t)b * SL;
    asm volatile("" : "+s"(Kg), "+s"(Vg));
    bf16x8 qf[12];
    { const bf16* qp = (const bf16*)(a.ws + AR_QF) + ((size_t)(b * 8 + h) * SL + qrow0 + r32) * 192 + 8 * hh;
#pragma unroll
      for (int s = 0; s < 12; ++s) qf[s] = *(const bf16x8*)(qp + 16 * s); }
    CBAR(); __builtin_amdgcn_sched_barrier(0);
    f32x16 o[4] = {};
    float mrun = -1e30f, lrun = 0.f;
    unsigned koff[4], voff[3];
#pragma unroll
    for (int i = 0; i < 4; ++i) { const int P = (w + 8 * i) * 64 + lane, row = P / 25, col = P - row * 25; koff[i] = (col < 24 && row < 64) ? (unsigned)(row * 384 + col * 16) : 0u; }
#pragma unroll
    for (int i = 0; i < 3; ++i) { const int P = (w + 8 * i) * 64 + lane, row = P / 9, col = P - row * 9; voff[i] = (col < 8 && row < 128) ? (unsigned)(row * (NT * 2) + col * 16) : 0u; }
#define AT_LOAD(j, bf) do { const char* kt = (const char*)Kg + (size_t)(j) * 64 * 384; const char* vt = (const char*)Vg + (size_t)(j) * 128; \
        _Pragma("unroll") for (int i = 0; i < 4; ++i) if (w + 8 * i < 25) __builtin_amdgcn_global_load_lds((const unsigned*)(kt + koff[i]), (LAS unsigned*)(lds + (bf) * AT_KB + (w + 8 * i) * 1024), 16, 0, 0); \
        _Pragma("unroll") for (int i = 0; i < 3; ++i) if (w + 8 * i < 18) __builtin_amdgcn_global_load_lds((const unsigned*)(vt + voff[i]), (LAS unsigned*)(lds + AT_VOFF + (bf) * AT_VB + (w + 8 * i) * 1024), 16, 0, 0); } while (0)
    AT_LOAD(0, 0);
    for (int j = 0; j < nt; ++j) {
        const int bf = j & 1;
        VM_WAIT(); __syncthreads(); CBAR();
        if (j + 1 < nt) AT_LOAD(j + 1, bf ^ 1);
        if (j * 64 <= qrow0 + 31) {
            f32x16 p0 = {}, p1 = {};
            const LAS unsigned char* kb = lds + bf * AT_KB + r32 * 400 + hh * 16;
#pragma unroll
            for (int s = 0; s < 12; ++s) {
                const bf16x8 a0 = *(const LAS bf16x8*)(kb + 32 * s), a1 = *(const LAS bf16x8*)(kb + 32 * 400 + 32 * s);
                p0 = __builtin_amdgcn_mfma_f32_32x32x16_bf16(a0, qf[s], p0, 0, 0, 0);
                p1 = __builtin_amdgcn_mfma_f32_32x32x16_bf16(a1, qf[s], p1, 0, 0, 0);
            }
            if (j * 64 + 63 > qrow0) {
                const int qpos = qrow0 + r32, kbase = j * 64 + 4 * hh;
#pragma unroll
                for (int r = 0; r < 16; ++r) { const int kk = kbase + (r & 3) + 8 * (r >> 2);
                    if (kk > qpos) p0[r] = -__builtin_inff();
                    if (kk + 32 > qpos) p1[r] = -__builtin_inff(); }
            }
            float mx = p0[0];
#pragma unroll
            for (int r = 1; r < 16; ++r) mx = fmaxf(mx, p0[r]);
#pragma unroll
            for (int r = 0; r < 16; ++r) mx = fmaxf(mx, p1[r]);
            mx = fmaxf(mx, __shfl_xor(mx, 32));
            const float mn = fmaxf(mrun, mx), alpha = __builtin_amdgcn_exp2f(mrun - mn); mrun = mn;
            float ps = 0.f;
#pragma unroll
            for (int r = 0; r < 16; ++r) { p0[r] = __builtin_amdgcn_exp2f(p0[r] - mn); ps += p0[r]; }
#pragma unroll
            for (int r = 0; r < 16; ++r) { p1[r] = __builtin_amdgcn_exp2f(p1[r] - mn); ps += p1[r]; }
            ps += __shfl_xor(ps, 32);
            lrun = lrun * alpha + ps;
#pragma unroll
            for (int d = 0; d < 4; ++d)
#pragma unroll
                for (int r = 0; r < 16; ++r) o[d][r] *= alpha;
            bf16x8 pb[4];
            { v4u x;
              x.x = pg8::cvt_pk_bf16(p0[0], p0[1]); x.y = pg8::cvt_pk_bf16(p0[2], p0[3]); x.z = pg8::cvt_pk_bf16(p0[4], p0[5]); x.w = pg8::cvt_pk_bf16(p0[6], p0[7]); pb[0] = __builtin_bit_cast(bf16x8, x);
              x.x = pg8::cvt_pk_bf16(p0[8], p0[9]); x.y = pg8::cvt_pk_bf16(p0[10], p0[11]); x.z = pg8::cvt_pk_bf16(p0[12], p0[13]); x.w = pg8::cvt_pk_bf16(p0[14], p0[15]); pb[1] = __builtin_bit_cast(bf16x8, x);
              x.x = pg8::cvt_pk_bf16(p1[0], p1[1]); x.y = pg8::cvt_pk_bf16(p1[2], p1[3]); x.z = pg8::cvt_pk_bf16(p1[4], p1[5]); x.w = pg8::cvt_pk_bf16(p1[6], p1[7]); pb[2] = __builtin_bit_cast(bf16x8, x);
              x.x = pg8::cvt_pk_bf16(p1[8], p1[9]); x.y = pg8::cvt_pk_bf16(p1[10], p1[11]); x.z = pg8::cvt_pk_bf16(p1[12], p1[13]); x.w = pg8::cvt_pk_bf16(p1[14], p1[15]); pb[3] = __builtin_bit_cast(bf16x8, x); }
            const LAS unsigned char* vb = lds + AT_VOFF + bf * AT_VB + r32 * 144 + hh * 8;
#pragma unroll
            for (int d = 0; d < 4; ++d)
#pragma unroll
                for (int s = 0; s < 4; ++s) {
                    const LAS unsigned char* vp = vb + d * 32 * 144 + s * 32;
                    const v2u lo = *(const LAS v2u*)vp, hi = *(const LAS v2u*)(vp + 16);
                    const v4u av = {lo.x, lo.y, hi.x, hi.y};
                    o[d] = __builtin_amdgcn_mfma_f32_32x32x16_bf16(__builtin_bit_cast(bf16x8, av), pb[s], o[d], 0, 0, 0);
                }
        }
    }
#undef AT_LOAD
    const float inv = 1.0f / lrun;
    bf16* opu = O + ((size_t)b * SL + qrow0) * 1024 + h * 128; const unsigned oo = (unsigned)(r32 * 1024 + 4 * hh);
    asm volatile("" : "+s"(opu));
#pragma unroll
    for (int d = 0; d < 4; ++d)
#pragma unroll
        for (int q = 0; q < 4; ++q) { v2u wv; wv.x = pk2(o[d][4 * q] * inv, o[d][4 * q + 1] * inv); wv.y = pk2(o[d][4 * q + 2] * inv, o[d][4 * q + 3] * inv);
            *(v2u*)(opu + (oo + 32 * d + 8 * q)) = wv; }
    __syncthreads();
}
__device__ __forceinline__ void attn_phase(const Frame& F, const Args& a) {
    for (int u = F.vcu; u < 256; u += F.G) {
        const int bh = u >> 2, x = u & 3;
        attn_block(F, a, bh >> 3, bh & 7, 7 - x);
        attn_block(F, a, bh >> 3, bh & 7, x);
    }
}

__device__ __forceinline__ void copy_out(const Frame& F, const float* src, float* dst) {
    for (size_t i = (size_t)F.gw * 64 + F.lane; i < (size_t)NT * DM / 4; i += (size_t)F.ngw * 64) ((f32x4*)dst)[i] = ((const f32x4*)src)[i];
}
template <int LAYER>
__device__ __forceinline__ void moe_block(Frame& F, const Args& a, const XcdBarrier& bar) {
#define MB_BAR() do { xcd_barrier(bar); asm volatile("" : "+v"(F.tid)); F.tid &= 511; F.lane = F.tid & 63; } while (0)
    unsigned char* ws = a.ws; PG8_LAS unsigned char* ring = (PG8_LAS unsigned char*)F.lds;
    float* const OUT = a.out; float* const X2 = (float*)(ws + WS_X2); bf16* const XN = (bf16*)(ws + WS_XN);
    if (PH(6)) RUNREP(6, norm_phase(F, OUT, a.in[31] + LAYER * 1024, XN));
    MB_BAR();
    if (PH(7)) router_phase(F, a, LAYER);
    MB_BAR();
    if (PH(8)) RUNREP(8, scatter_phase(F, a, LAYER));
    MB_BAR();
    if (PH(9)) {
        pg8::GroupedOrder S{(const PG8_LAS int*)(F.lds + TAB_OFF + 256), ((const LAS int*)(F.lds + TAB_OFF))[64 + MAX_RT], 2, F.G, F.vcu};
        pg8::Gemm g{(const bf16*)(ws + AR_XDISP), (const bf16*)(ws + WS_W13), MAX_RT * 256, 64 * 512, 1024};
        pg8::EpiSwiGlu E{(bf16*)(ws + AR_H)};
        pg8::gemm_phase<pg8::EpiSwiGlu, pg8::GroupedOrder>(ring, g, S, E, nullptr);
    }
    MB_BAR();
    if (PH(10)) {
        pg8::GroupedOrder S{(const PG8_LAS int*)(F.lds + TAB_OFF + 256), ((const LAS int*)(F.lds + TAB_OFF))[64 + MAX_RT], 4, F.G, F.vcu};
        int k2 = 256; asm volatile("" : "+s"(k2));
        pg8::Gemm g{(const bf16*)(ws + AR_H), (const bf16*)(ws + WS_W2), MAX_RT * 256, 64 * 1024, k2};
        pg8::EpiBf16N E{(bf16*)(ws + AR_YDISP), 1024, 4};
        pg8::gemm_phase<pg8::EpiBf16N, pg8::GroupedOrder>(ring, g, S, E, nullptr);
    }
    MB_BAR();
    if (PH(17)) { if (LAYER == 0) combine_phase<true>(F, a, OUT, X2, a.in[22], XN); else combine_phase<false>(F, a, OUT, OUT, nullptr, nullptr); }
}
__global__ void __launch_bounds__(NWAVES * 64, 2) fwd_kernel(Args a) {
    extern __shared__ __attribute__((aligned(16))) unsigned char lds_raw[];
    Frame F;
    F.lds = (LAS unsigned char*)lds_raw;
    F.tid = threadIdx.x; F.lane = F.tid & 63; F.wave = __builtin_amdgcn_readfirstlane(F.tid >> 6);
    F.G = gridDim.x; { const int bx = blockIdx.x; F.vcu = (F.G % 8 == 0) ? (bx % 8) * (F.G / 8) + bx / 8 : bx; }
    F.gw = F.vcu * NWAVES + F.wave; F.ngw = F.G * NWAVES;
    volatile LAS unsigned* MISC = (volatile LAS unsigned*)(F.lds + MISC_OFF);
    for (int u = F.tid; u < (LDS_BYTES - TAB_OFF) / 4; u += NWAVES * 64) ((LAS unsigned*)(F.lds + TAB_OFF))[u] = 0u;
    __syncthreads();
    unsigned char* ws = a.ws;
    XcdBarrier bar = xcd_barrier_post((unsigned*)(ws + WS_CTL) + CW_BAR, MISC + 8);
#define RELAUNDER() do { asm volatile("" : "+v"(F.tid)); F.tid &= 511; F.lane = F.tid & 63; } while (0)
#define GRID_BAR() do { xcd_barrier(bar); RELAUNDER(); } while (0)
    PG8_LAS unsigned char* ring = (PG8_LAS unsigned char*)F.lds;
    const int G = F.G, bx = (int)blockIdx.x;
    float* const OUT = a.out; float* const X2 = (float*)(ws + WS_X2); bf16* const XN = (bf16*)(ws + WS_XN);

    if (PH(0)) RUNREP(0, p0_prologue(F, a));
    for (int xb = 0; xb < XBARS; ++xb) xcd_barrier(bar);
    GRID_BAR();
    if (PH(1)) {
        pg8::Gemm g{XN, (const bf16*)(ws + WS_WIN), NT, 1536, 1024}; pg8::StaticOrder S; S.init(NT, 1536, G, bx);
        pg8::EpiBf16N E{(bf16*)(ws + AR_PROJ), 1536, 1 << 20};
        pg8::gemm_phase<pg8::EpiBf16N, pg8::StaticOrder>(ring, g, S, E, nullptr);
    }
    GRID_BAR();
    RUNREP(2, mixers_a(F, a));
    GRID_BAR();
    RUNREP(3, mixers_b(F, a));
    if (PH(4)) {
        pg8::Gemm g{(const bf16*)(ws + AR_YAPRE), (const bf16*)(ws + WS_GLU), NT, 512, 512}; pg8::StaticOrder S; S.init(NT, 512, G, bx);
        pg8::EpiGlu E{(const bf16*)(ws + AR_YAPRE), 512, (bf16*)(ws + AR_YCAT), 1024, a.in[13]};
        pg8::gemm_phase<pg8::EpiGlu, pg8::StaticOrder>(ring, g, S, E, nullptr);
    }
    GRID_BAR();
    if (PH(5)) {
        pg8::Gemm g{(const bf16*)(ws + AR_YCAT), (const bf16*)(ws + WS_WOUT), NT, 1024, 1024}; pg8::StaticOrder S; S.init(NT, 1024, G, bx);
        pg8::EpiResF32 E{a.in[0], OUT, 1024};
        pg8::gemm_phase<pg8::EpiResF32, pg8::StaticOrder>(ring, g, S, E, nullptr);
    }
    if (STOP_AFTER <= 5) return;
    GRID_BAR();
    moe_block<0>(F, a, bar);
    if (STOP_AFTER <= 10) { GRID_BAR(); copy_out(F, X2, OUT); return; }
    GRID_BAR();
    if (PH(11)) {
        pg8::Gemm g{XN, (const bf16*)(ws + WS_MIN), NT, 768, 1024}; pg8::StaticOrder S; S.init(NT, 768, G, bx);
        pg8::EpiMlaIn E{(bf16*)(ws + AR_CQR), (bf16*)(ws + AR_CKVR), (bf16*)(ws + AR_KRR)};
        pg8::gemm_phase<pg8::EpiMlaIn, pg8::StaticOrder>(ring, g, S, E, nullptr);
    }
    GRID_BAR();
    if (PH(12)) RUNREP(12, mla_lora_norm_phase(F, a); conv_moe(F, a, 1, (LAS float*)(F.lds + F.wave * WSCR)));
    GRID_BAR();
    if (PH(13)) {
        { pg8::Gemm g{(const bf16*)(ws + AR_CQ), (const bf16*)(ws + WS_UQ), NT, 1536, 384}; pg8::StaticOrder S; S.init(NT, 1536, G, bx);
          pg8::EpiBf16N E{(bf16*)(ws + AR_QRAW), 1536, 1 << 20}; pg8::gemm_phase<pg8::EpiBf16N, pg8::StaticOrder>(ring, g, S, E, nullptr); }
        CBAR(); __syncthreads(); CBAR();
        { pg8::Gemm g{(const bf16*)(ws + AR_CKV), (const bf16*)(ws + WS_UK), NT, 1024, 256}; pg8::StaticOrder S; S.init(NT, 1024, G, bx);
          pg8::EpiBf16N E{(bf16*)(ws + AR_KNRAW), 1024, 1 << 20}; pg8::gemm_phase<pg8::EpiBf16N, pg8::StaticOrder>(ring, g, S, E, nullptr); }
        CBAR(); __syncthreads(); CBAR();
        { pg8::Gemm g{(const bf16*)(ws + WS_UV), (const bf16*)(ws + AR_CKV), 1024, NT, 256}; pg8::StaticOrder S; S.init(1024, NT, G, bx);
          pg8::EpiBf16N E{(bf16*)(ws + AR_VT), NT, 1 << 20}; pg8::gemm_phase<pg8::EpiBf16N, pg8::StaticOrder>(ring, g, S, E, nullptr); }
    }
    GRID_BAR();
    if (PH(14)) RUNREP(14, mla_qk_phase(F, a));
    GRID_BAR();
    if (PH(15)) RUNREP(15, attn_phase(F, a));
    GRID_BAR();
    if (PH(16)) {
        pg8::Gemm g{(const bf16*)(ws + AR_O), (const bf16*)(ws + WS_WO), NT, 1024, 1024}; pg8::StaticOrder S; S.init(NT, 1024, G, bx);
        pg8::EpiResF32 E{X2, OUT, 1024};
        pg8::gemm_phase<pg8::EpiResF32, pg8::StaticOrder>(ring, g, S, E, nullptr);
    }
    if (STOP_AFTER <= 16) return;
    GRID_BAR();
    moe_block<1>(F, a, bar);
}

extern "C" void kernel_launch(void* const* d_in, const int* in_sizes, int n_in, void* d_out, int out_size, void* d_ws, size_t ws_size, hipStream_t stream) {
    static int grid = 0;
    if (grid == 0) {
        if (n_in != 39 || out_size != NT * DM || ws_size < WS_END) { fprintf(stderr, "kernel_launch: unexpected shapes (n_in %d out %d ws %zu, need %zu)\n", n_in, out_size, ws_size, (size_t)WS_END); grid = -1; return; }
        int dev = 0, cus = 0, per_cu = 0;
        if (hipGetDevice(&dev) != hipSuccess || hipDeviceGetAttribute(&cus, hipDeviceAttributeMultiprocessorCount, dev) != hipSuccess) { grid = -1; return; }
        if (hipFuncSetAttribute((const void*)fwd_kernel, hipFuncAttributeMaxDynamicSharedMemorySize, LDS_BYTES) != hipSuccess) { fprintf(stderr, "kernel_launch: hipFuncSetAttribute failed\n"); grid = -1; return; }
        if (hipOccupancyMaxActiveBlocksPerMultiprocessor(&per_cu, (const void*)fwd_kernel, NWAVES * 64, LDS_BYTES) != hipSuccess || per_cu < 1) { fprintf(stderr, "kernel_launch: occupancy query says %d\n", per_cu); }
        (void)hipGetLastError();
        grid = cus;
    }
    if (grid < 0) return;
    (void)hipMemsetAsync((char*)d_ws + WS_CTL, 0, CTL_ZERO_BYTES, stream);
    Args a{};
    for (int i = 0; i < 39; ++i) a.in[i] = (const float*)d_in[i];
    a.pos = (const int*)d_in[1]; a.out = (float*)d_out; a.ws = (unsigned char*)d_ws;
    hipLaunchKernelGGL(fwd_kernel, dim3(grid), dim3(NWAVES * 64), LDS_BYTES, stream, a);
}
```

```cpp
#include <hip/hip_runtime.h>
#include <cstdio>
#include <cstdint>
namespace pg8 {
#define PG8_LAS __attribute__((address_space(3)))
typedef unsigned short bf16_t;
typedef short bf16x8 __attribute__((ext_vector_type(8)));
typedef float f32x4 __attribute__((ext_vector_type(4)));
typedef unsigned u32x4 __attribute__((ext_vector_type(4)));
constexpr int BM = 256, BK = 64, HALF = 128, HTB = HALF * BK * 2  , STAGE_BYTES = 8 * HTB, NXCD = 8, WGM = 8;

__host__ __device__ __forceinline__ int lds_byte(int r, int c) { const int st = (r >> 4) * 2 + (c >> 5), rr = r & 15, cc = c & 31, ob = rr * 64 + cc * 2; return st * 1024 + (ob ^ (((ob >> 9) & 1) << 5)); }
__host__ __device__ __forceinline__ void stage_rc(int b, int& R, int& C) { const int st = b / 1024, sb = b % 1024, swz = sb ^ (((sb >> 9) & 1) << 5); R = (st >> 1) * 16 + swz / 64; C = (st & 1) * 32 + (swz % 64) / 2; }
__host__ __device__ __forceinline__ int perm32(int rho) { const int n = rho >> 4, i = rho & 15; return 8 * (i >> 2) + 4 * n + (i & 3); }

struct Unit { int pm, pn; };
struct Gemm { const bf16_t* A; const bf16_t* Bt; int M, N, K; };

struct StaticOrder {
    int nM, nN, nwg, G, c;
    __host__ __device__ void init(int M, int N, int G_, int c_) { nM = M / BM; nN = N / BM; nwg = nM * nN; G = G_; c = c_; }
    __host__ __device__ bool next(int i, Unit& u) const {
        const long L = (long)i * G + c; if (L >= nwg) return false;
        int wgid = (int)L; { const int q = nwg / NXCD, r = nwg % NXCD, xcd = wgid % NXCD, off = wgid / NXCD; wgid = (xcd < r ? xcd * (q + 1) : r * (q + 1) + (xcd - r) * q) + off; }
        const int nig = WGM * nN, gid = wgid / nig, fm = gid * WGM, gsz = (nM - fm) < WGM ? (nM - fm) : WGM;
        u.pm = fm + ((wgid % nig) % gsz); u.pn = (wgid % nig) / gsz; return true;
    }
    __device__ __forceinline__ void a_ready(const Unit&) const {}
    __device__ __forceinline__ void done(const Unit&) const {}
};
struct CountedOrder : StaticOrder {
    const unsigned* ready; unsigned need; unsigned* tmo;
    __device__ __forceinline__ void a_ready(const Unit& u) const {
        if (threadIdx.x < 64) {
            const unsigned long long t0 = __builtin_amdgcn_s_memrealtime(); unsigned polls = 0;
            while ((unsigned)__builtin_amdgcn_readfirstlane(__hip_atomic_load(ready + 64 * u.pm, __ATOMIC_RELAXED, __HIP_MEMORY_SCOPE_AGENT)) < need) {
                if ((++polls & 255u) == 0u && __builtin_amdgcn_readfirstlane(__hip_atomic_load(tmo, __ATOMIC_RELAXED, __HIP_MEMORY_SCOPE_AGENT)) != 0u) break;
                if (__builtin_amdgcn_s_memrealtime() - t0 > 2000000ull) {
                    if (threadIdx.x == 0) { unsigned expect = 0u; __hip_atomic_compare_exchange_strong(tmo + 1, &expect, 0x600u | (unsigned)(u.pm & 0xff), __ATOMIC_RELAXED, __ATOMIC_RELAXED, __HIP_MEMORY_SCOPE_AGENT); __hip_atomic_store(tmo, 1u, __ATOMIC_RELAXED, __HIP_MEMORY_SCOPE_AGENT); }
                    break; }
                __builtin_amdgcn_s_sleep(2); }
            __builtin_amdgcn_fence(__ATOMIC_ACQUIRE, "agent");
            asm volatile("s_waitcnt vmcnt(0)" ::: "memory");
        }
#if !defined(BROKEN_HOOK_NO_BARRIER)
        asm volatile("" ::: "memory"); __builtin_amdgcn_s_barrier(); asm volatile("" ::: "memory");
#endif
    }
};

__device__ __forceinline__ unsigned cvt_pk_bf16(float lo, float hi) { unsigned r; asm volatile("v_cvt_pk_bf16_f32 %0, %1, %2" : "=v"(r) : "v"(lo), "v"(hi)); return r; }
typedef float f32x2 __attribute__((ext_vector_type(2)));
__device__ __forceinline__ f32x2 gelu_pk(f32x2 v) {
    const f32x2 av = __builtin_elementwise_abs(v), d = av * 0.2316418882f + 1.0f;
    f32x2 t; t.x = __builtin_amdgcn_rcpf(d.x); t.y = __builtin_amdgcn_rcpf(d.y);
    f32x2 q = t * 0.5307027145f + (-0.7265760135f); q = q * t + 0.7107068705f; q = q * t + (-0.142248368f); q = q * t + 0.127414796f; q = q * t;
    const f32x2 s = (v * v) * (-0.72134752044f);
    f32x2 e; e.x = __builtin_amdgcn_exp2f(s.x); e.y = __builtin_amdgcn_exp2f(s.y);
    const f32x2 m = v * (q * e), r = v - m;
    f32x2 o; o.x = v.x < 0.f ? m.x : r.x; o.y = v.y < 0.f ? m.y : r.y; return o;
}

struct EpiF32 {
    static constexpr bool PERM = false, AFTER_DRAIN = false;
    float* C; int ldc; const float* bias;
    __device__ __forceinline__ void operator()(const f32x4 (&acc)[2][2][4][2], const Unit& u, int wr, int wc, int fr, int fq) const {
        const int row0 = u.pm * BM + wr * 64 + fr, col0 = u.pn * BM + wc * 32 + 4 * fq;
        f32x4 bv[2][2];
#pragma unroll
        for (int bj = 0; bj < 2; ++bj)
#pragma unroll
            for (int n = 0; n < 2; ++n) bv[bj][n] = bias ? *(const f32x4*)(bias + col0 + bj * HALF + n * 16) : (f32x4){0.f, 0.f, 0.f, 0.f};
#pragma unroll
        for (int ai = 0; ai < 2; ++ai)
#pragma unroll
            for (int m = 0; m < 4; ++m) { float* rowp = C + (size_t)(row0 + ai * HALF + m * 16) * ldc + col0;
#pragma unroll
                for (int bj = 0; bj < 2; ++bj)
#pragma unroll
                    for (int n = 0; n < 2; ++n) *(f32x4*)(rowp + bj * HALF + n * 16) = acc[ai][bj][m][n] + bv[bj][n]; }
    }
};
template <int ACT  > struct EpiBf16 {
    static constexpr bool PERM = true, AFTER_DRAIN = false;
    bf16_t* O; int ldc; const float* bias; int split_cols; size_t split_stride;
    __device__ __forceinline__ void operator()(const f32x4 (&acc)[2][2][4][2], const Unit& u, int wr, int wc, int fr, int fq) const {
        const int row0 = u.pm * BM + wr * 64 + fr; int colt = u.pn * BM; bf16_t* base = O;
        if (split_cols) { const int t = colt / split_cols; base += (size_t)t * split_stride; colt -= t * split_cols; }
        const int col0 = colt + wc * 32 + 8 * fq, bcol0 = u.pn * BM + wc * 32 + 8 * fq;
        f32x4 bv[2][2];
#pragma unroll
        for (int bj = 0; bj < 2; ++bj)
#pragma unroll
            for (int n = 0; n < 2; ++n) bv[bj][n] = bias ? *(const f32x4*)(bias + bcol0 + bj * HALF + 4 * n) : (f32x4){0.f, 0.f, 0.f, 0.f};
#pragma unroll
        for (int ai = 0; ai < 2; ++ai)
#pragma unroll
            for (int m = 0; m < 4; ++m) { bf16_t* rowp = base + (size_t)(row0 + ai * HALF + m * 16) * ldc + col0;
#pragma unroll
                for (int bj = 0; bj < 2; ++bj) { f32x4 v0 = acc[ai][bj][m][0] + bv[bj][0], v1 = acc[ai][bj][m][1] + bv[bj][1];
                    if (ACT == 1) { f32x2 a = gelu_pk((f32x2){v0[0], v0[1]}), b = gelu_pk((f32x2){v0[2], v0[3]}), c = gelu_pk((f32x2){v1[0], v1[1]}), d = gelu_pk((f32x2){v1[2], v1[3]});
                        v0 = (f32x4){a.x, a.y, b.x, b.y}; v1 = (f32x4){c.x, c.y, d.x, d.y}; }
                    if (ACT == 2) {
#pragma unroll
                        for (int j = 0; j < 4; ++j) { v0[j] = 0.5f * v0[j] * (1.0f + erff(v0[j] * 0.70710678f)); v1[j] = 0.5f * v1[j] * (1.0f + erff(v1[j] * 0.70710678f)); } }
                    u32x4 w; w.x = cvt_pk_bf16(v0[0], v0[1]); w.y = cvt_pk_bf16(v0[2], v0[3]); w.z = cvt_pk_bf16(v1[0], v1[1]); w.w = cvt_pk_bf16(v1[2], v1[3]);
                    *(u32x4*)(rowp + bj * HALF) = w; } }
    }
};
__device__ __forceinline__ float bf2f(unsigned b16) { return __uint_as_float(b16 << 16); }
__device__ __forceinline__ float bflo(unsigned w) { return __uint_as_float(w << 16); }
__device__ __forceinline__ float bfhi(unsigned w) { return __uint_as_float(w & 0xffff0000u); }
__device__ __forceinline__ float sigm(float x) { return 1.0f / (1.0f + __expf(-x)); }

struct EpiResF32 {
    static constexpr bool PERM = false, AFTER_DRAIN = false;
    const float* res; float* out; int ldc;
    __device__ __forceinline__ void operator()(const f32x4 (&acc)[2][2][4][2], const Unit& u, int wr, int wc, int fr, int fq) const {
        const int row0 = u.pm * BM + wr * 64 + fr, col0 = u.pn * BM + wc * 32 + 4 * fq;
#pragma unroll
        for (int ai = 0; ai < 2; ++ai)
#pragma unroll
            for (int m = 0; m < 4; ++m) { const size_t off = (size_t)(row0 + ai * HALF + m * 16) * ldc + col0;
#pragma unroll
                for (int bj = 0; bj < 2; ++bj)
#pragma unroll
                    for (int n = 0; n < 2; ++n) { const f32x4 r = *(const f32x4*)(res + off + bj * HALF + n * 16); *(f32x4*)(out + off + bj * HALF + n * 16) = acc[ai][bj][m][n] + r; } }
    }
};
struct EpiBf16N {
    static constexpr bool PERM = true, AFTER_DRAIN = false;
    bf16_t* O; int ldc; int nct;
    __device__ __forceinline__ void operator()(const f32x4 (&acc)[2][2][4][2], const Unit& u, int wr, int wc, int fr, int fq) const {
        const int row0 = u.pm * BM + wr * 64 + fr, col0 = (u.pn % nct) * BM + wc * 32 + 8 * fq;
#pragma unroll
        for (int ai = 0; ai < 2; ++ai)
#pragma unroll
            for (int m = 0; m < 4; ++m) { bf16_t* rowp = O + (size_t)(row0 + ai * HALF + m * 16) * ldc + col0;
#pragma unroll
                for (int bj = 0; bj < 2; ++bj) { const f32x4 v0 = acc[ai][bj][m][0], v1 = acc[ai][bj][m][1];
                    u32x4 w; w.x = cvt_pk_bf16(v0[0], v0[1]); w.y = cvt_pk_bf16(v0[2], v0[3]); w.z = cvt_pk_bf16(v1[0], v1[1]); w.w = cvt_pk_bf16(v1[2], v1[3]);
                    *(u32x4*)(rowp + bj * HALF) = w; } }
    }
};
struct EpiGlu {
    static constexpr bool PERM = true, AFTER_DRAIN = false;
    const bf16_t* Y; int ldy; bf16_t* O; int ldo; const float* bias;
    __device__ __forceinline__ void operator()(const f32x4 (&acc)[2][2][4][2], const Unit& u, int wr, int wc, int fr, int fq) const {
        const int row0 = u.pm * BM + wr * 64 + fr, col0 = u.pn * BM + wc * 32 + 8 * fq;
        f32x4 bv[2][2];
#pragma unroll
        for (int bj = 0; bj < 2; ++bj)
#pragma unroll
            for (int n = 0; n < 2; ++n) bv[bj][n] = *(const f32x4*)(bias + col0 + bj * HALF + 4 * n);
#pragma unroll
        for (int ai = 0; ai < 2; ++ai)
#pragma unroll
            for (int m = 0; m < 4; ++m) { const int r = row0 + ai * HALF + m * 16;
#pragma unroll
                for (int bj = 0; bj < 2; ++bj) { const int c = col0 + bj * HALF;
                    const u32x4 yv = *(const u32x4*)(Y + (size_t)r * ldy + c);
                    const f32x4 v0 = acc[ai][bj][m][0] + bv[bj][0], v1 = acc[ai][bj][m][1] + bv[bj][1];
                    u32x4 w;
                    w.x = cvt_pk_bf16(bflo(yv.x) * sigm(v0[0]), bfhi(yv.x) * sigm(v0[1]));
                    w.y = cvt_pk_bf16(bflo(yv.y) * sigm(v0[2]), bfhi(yv.y) * sigm(v0[3]));
                    w.z = cvt_pk_bf16(bflo(yv.z) * sigm(v1[0]), bfhi(yv.z) * sigm(v1[1]));
                    w.w = cvt_pk_bf16(bflo(yv.w) * sigm(v1[2]), bfhi(yv.w) * sigm(v1[3]));
                    *(u32x4*)(O + (size_t)r * ldo + c) = w; } }
    }
};
struct EpiSwiGlu {
    static constexpr bool PERM = true, AFTER_DRAIN = false;
    bf16_t* H;
    __device__ __forceinline__ void operator()(const f32x4 (&acc)[2][2][4][2], const Unit& u, int wr, int wc, int fr, int fq) const {
        const int row0 = u.pm * BM + wr * 64 + fr, col0 = (u.pn & 1) * HALF + wc * 32 + 8 * fq;
#pragma unroll
        for (int ai = 0; ai < 2; ++ai)
#pragma unroll
            for (int m = 0; m < 4; ++m) { const int r = row0 + ai * HALF + m * 16;
                float o[8];
#pragma unroll
                for (int n = 0; n < 2; ++n)
#pragma unroll
                    for (int i = 0; i < 4; ++i) { const float a1 = acc[ai][0][m][n][i], a3 = acc[ai][1][m][n][i]; o[4 * n + i] = a1 * sigm(a1) * a3; }
                u32x4 w; w.x = cvt_pk_bf16(o[0], o[1]); w.y = cvt_pk_bf16(o[2], o[3]); w.z = cvt_pk_bf16(o[4], o[5]); w.w = cvt_pk_bf16(o[6], o[7]);
                *(u32x4*)(H + (size_t)r * 256 + col0) = w; }
    }
};
struct EpiMlaIn {
    static constexpr bool PERM = true, AFTER_DRAIN = false;
    bf16_t* CQ; bf16_t* CKV; bf16_t* KR;
    __device__ __forceinline__ void operator()(const f32x4 (&acc)[2][2][4][2], const Unit& u, int wr, int wc, int fr, int fq) const {
        const int row0 = u.pm * BM + wr * 64 + fr, col0 = u.pn * BM + wc * 32 + 8 * fq;
#pragma unroll
        for (int ai = 0; ai < 2; ++ai)
#pragma unroll
            for (int m = 0; m < 4; ++m) { const int r = row0 + ai * HALF + m * 16;
#pragma unroll
                for (int bj = 0; bj < 2; ++bj) { const int c = col0 + bj * HALF; const f32x4 v0 = acc[ai][bj][m][0], v1 = acc[ai][bj][m][1];
                    u32x4 w; w.x = cvt_pk_bf16(v0[0], v0[1]); w.y = cvt_pk_bf16(v0[2], v0[3]); w.z = cvt_pk_bf16(v1[0], v1[1]); w.w = cvt_pk_bf16(v1[2], v1[3]);
                    if (c < 384) *(u32x4*)(CQ + (size_t)r * 384 + c) = w;
                    else if (c < 640) *(u32x4*)(CKV + (size_t)r * 256 + (c - 384)) = w;
                    else if (c < 704) *(u32x4*)(KR + (size_t)r * 64 + (c - 640)) = w; } }
    }
};
struct GroupedOrder {
    const PG8_LAS int* tile_e; int n_rt, nct, G, c;
    const PG8_LAS int* pads; const PG8_LAS int* cnts; const int* slot; int cap;
    __device__ __forceinline__ bool next(int i, Unit& u) const {
        const int L = i * G + c; if (L >= n_rt * nct) return false;
        const int rt = L / nct, j = L - rt * nct; u.pm = rt; u.pn = tile_e[rt] * nct + j; return true; }
    __device__ __forceinline__ int gather_row(const Unit& u, int r) const {
        const int e = tile_e[u.pm], idx = u.pm * 256 - pads[e] + r;
        return (idx < cnts[e]) ? slot[(size_t)e * cap + idx] : 0; }
    __device__ __forceinline__ void a_ready(const Unit&) const {}
    __device__ __forceinline__ void done(const Unit&) const {}
};
template <class Epi, class Sched, bool STAMP = false, bool GATHER = false>
__device__ __forceinline__ void gemm_phase(PG8_LAS unsigned char* lds, const Gemm g, const Sched& S, const Epi& E, unsigned long long* stamps) {
    int tid_ = threadIdx.x; asm volatile("" : "+v"(tid_));
    const int tid = tid_, wid = __builtin_amdgcn_readfirstlane(tid >> 6), lane = tid & 63, wr = wid >> 2, wc = wid & 3, fr = lane & 15, fq = lane >> 4;
    const int K = g.K, nt = K / BK;
    int ts_lo = 0, ts_hi = 0, nts = 0; const unsigned long long rt_entry = STAMP ? (unsigned long long)wall_clock64() : 0ull;
#define PG8_STAMP() do { if (STAMP && wid == 0 && nts < 64) { const unsigned long long _c = (unsigned long long)clock64(); \
        ts_lo = (lane == nts) ? (int)(unsigned)_c : ts_lo; ts_hi = (lane == nts) ? (int)(unsigned)(_c >> 32) : ts_hi; ++nts; } } while (0)
    PG8_STAMP();
    unsigned voffA[2], voffB[2]; int gR[2]; unsigned gC[2];
#pragma unroll
    for (int i = 0; i < 2; ++i) { int R, C; stage_rc(tid * 16 + i * 8192, R, C); const int Rb = Epi::PERM ? ((R & ~31) + perm32(R & 31)) : R;
        voffA[i] = (unsigned)(R * K + C) * 2u; voffB[i] = (unsigned)(Rb * K + C) * 2u; gR[i] = R; gC[i] = (unsigned)C * 2u; }
    unsigned vgC[2][2] = {{0u, 0u}, {0u, 0u}}, vgN[2][2] = {{0u, 0u}, {0u, 0u}};
    const size_t kstep = (size_t)(BK * 2);
    const size_t hstep = (size_t)HALF * K * 2;
    const size_t tstep = 2 * hstep;
    const size_t hstepA = GATHER ? 0 : hstep, tstepA = GATHER ? 0 : tstep;
    const unsigned ldsw = (unsigned)wid * 1024u;
    const int aoff = lds_byte(wr * 64 + fr, fq * 8), boff = lds_byte(wc * 32 + fr, fq * 8);
#define PG8_SA(b, h) (((b) * 2 + (h)) * HTB)
#define PG8_SB(b, h) ((4 + (b) * 2 + (h)) * HTB)
#define PG8_STAGE(bufoff, gbase, voff) do { _Pragma("unroll") for (int _i = 0; _i < 2; ++_i) \
        __builtin_amdgcn_global_load_lds((const unsigned*)((const char*)(gbase) + (voff)[_i]), (PG8_LAS unsigned*)(lds + (bufoff) + ldsw + _i * 8192), 16, 0, 0); } while (0)
#define PG8_STAGE_A(bufoff, gbase, half, usenext) do { if constexpr (GATHER) { _Pragma("unroll") for (int _i = 0; _i < 2; ++_i) \
        __builtin_amdgcn_global_load_lds((const unsigned*)((const char*)(gbase) + ((usenext) ? vgN[half][_i] : vgC[half][_i])), (PG8_LAS unsigned*)(lds + (bufoff) + ldsw + _i * 8192), 16, 0, 0); } \
        else { PG8_STAGE(bufoff, (const char*)(gbase) + (half) * hstep, voffA); } } while (0)
#define PG8_GOFF(dst, unit) do { if constexpr (GATHER) { _Pragma("unroll") for (int _h = 0; _h < 2; ++_h) _Pragma("unroll") for (int _i = 0; _i < 2; ++_i) \
        dst[_h][_i] = (unsigned)S.gather_row(unit, _h * HALF + gR[_i]) * (unsigned)(K * 2) + gC[_i]; } } while (0)
#define PG8_LDA(dst, b, h) do { _Pragma("unroll") for (int m = 0; m < 4; ++m) _Pragma("unroll") for (int k = 0; k < 2; ++k) dst[m][k] = *(const PG8_LAS bf16x8*)(lds + PG8_SA(b, h) + aoff + m * 2048 + k * 1024); } while (0)
#define PG8_LDB(dst, b, h) do { _Pragma("unroll") for (int n = 0; n < 2; ++n) _Pragma("unroll") for (int k = 0; k < 2; ++k) dst[n][k] = *(const PG8_LAS bf16x8*)(lds + PG8_SB(b, h) + boff + n * 2048 + k * 1024); } while (0)
#define PG8_MMA(ai, bj, At, Bt) do { __builtin_amdgcn_s_setprio(1); _Pragma("unroll") for (int m = 0; m < 4; ++m) _Pragma("unroll") for (int n = 0; n < 2; ++n) _Pragma("unroll") for (int k = 0; k < 2; ++k) \
        acc[ai][bj][m][n] = __builtin_amdgcn_mfma_f32_16x16x32_bf16(Bt[n][k], At[m][k], acc[ai][bj][m][n], 0, 0, 0); __builtin_amdgcn_s_setprio(0); } while (0)
#define PG8_WAIT_V(n) asm volatile("s_waitcnt vmcnt(" #n ")" ::: "memory")
#define PG8_WAIT_L(n) asm volatile("s_waitcnt lgkmcnt(" #n ")" ::: "memory")
#define PG8_BAR __builtin_amdgcn_s_barrier()
#define PG8_SCHED __builtin_amdgcn_sched_barrier(0)
    Unit cur, nxt; int ui = 0;
    if (!S.next(0, cur)) return;
    f32x4 acc[2][2][4][2];
#pragma unroll
    for (int a = 0; a < 2; ++a)
#pragma unroll
        for (int b = 0; b < 2; ++b)
#pragma unroll
            for (int m = 0; m < 4; ++m)
#pragma unroll
                for (int n = 0; n < 2; ++n) acc[a][b][m][n] = (f32x4){0.f, 0.f, 0.f, 0.f};
    bf16x8 At[4][2], B0[2][2], B1[2][2];
    const char* cA = (const char*)g.A + (size_t)cur.pm * tstepA; const char* cB = (const char*)g.Bt + (size_t)cur.pn * tstep;
    S.a_ready(cur);
    PG8_GOFF(vgC, cur);
    PG8_STAGE(PG8_SB(0, 0), cB, voffB); PG8_STAGE_A(PG8_SA(0, 0), cA, 0, false); PG8_STAGE(PG8_SB(0, 1), cB + hstep, voffB); PG8_STAGE_A(PG8_SA(0, 1), cA, 1, false);
    if (wr == 1) PG8_BAR;
    PG8_WAIT_V(4); PG8_BAR;
    PG8_STAGE(PG8_SB(1, 0), cB + kstep, voffB); PG8_STAGE_A(PG8_SA(1, 0), cA + kstep, 0, false); PG8_STAGE(PG8_SB(1, 1), cB + hstep + kstep, voffB);
    PG8_WAIT_V(6); PG8_BAR;
    PG8_STAMP();
    for (;;) {
        const bool has_next = S.next(ui + 1, nxt);
        const char* nA = has_next ? (const char*)g.A + (size_t)nxt.pm * tstepA : cA; const char* nB = has_next ? (const char*)g.Bt + (size_t)nxt.pn * tstep : cB;
        if constexpr (GATHER) { if (has_next) { PG8_GOFF(vgN, nxt); } else { _Pragma("unroll") for (int _h = 0; _h < 2; ++_h) _Pragma("unroll") for (int _i = 0; _i < 2; ++_i) vgN[_h][_i] = vgC[_h][_i]; } }
        for (int t = 0; t < nt; t += 2) {
            const bool last = (t == nt - 2);
            const char* a1 = cA + (size_t)(t + 1) * kstep;
            const char* a2 = last ? nA : cA + (size_t)(t + 2) * kstep; const char* b2 = last ? nB : cB + (size_t)(t + 2) * kstep;
            const char* a3 = a2 + kstep; const char* b3 = b2 + kstep;
            if (last && has_next) S.a_ready(nxt);
            PG8_LDB(B0, 0, 0); PG8_SCHED; PG8_LDA(At, 0, 0); PG8_STAGE_A(PG8_SA(1, 1), a1, 1, false);
            PG8_WAIT_L(8); PG8_BAR; PG8_WAIT_L(0); PG8_MMA(0, 0, At, B0); PG8_BAR; PG8_SCHED;
            PG8_LDB(B1, 0, 1); PG8_STAGE(PG8_SB(0, 0), b2, voffB);
            PG8_BAR; PG8_WAIT_L(0); PG8_MMA(0, 1, At, B1); PG8_BAR;
            PG8_LDA(At, 0, 1); PG8_STAGE_A(PG8_SA(0, 0), a2, 0, last);
            PG8_BAR; PG8_WAIT_L(0); PG8_MMA(1, 0, At, B0); PG8_BAR; PG8_SCHED;
            PG8_STAGE(PG8_SB(0, 1), b2 + hstep, voffB);
            PG8_WAIT_V(6); PG8_BAR; PG8_MMA(1, 1, At, B1); PG8_BAR;
            PG8_LDB(B0, 1, 0); PG8_SCHED; PG8_LDA(At, 1, 0); PG8_STAGE_A(PG8_SA(0, 1), a2, 1, last);
            PG8_WAIT_L(8); PG8_BAR; PG8_WAIT_L(0); PG8_MMA(0, 0, At, B0); PG8_BAR; PG8_SCHED;
            PG8_LDB(B1, 1, 1); PG8_STAGE(PG8_SB(1, 0), b3, voffB);
            PG8_BAR; PG8_WAIT_L(0); PG8_MMA(0, 1, At, B1); PG8_BAR;
            PG8_LDA(At, 1, 1); PG8_STAGE_A(PG8_SA(1, 0), a3, 0, last);
            PG8_BAR; PG8_WAIT_L(0); PG8_MMA(1, 0, At, B0); PG8_BAR; PG8_SCHED;
            PG8_STAGE(PG8_SB(1, 1), b3 + hstep, voffB);
            PG8_WAIT_V(6); PG8_BAR; PG8_MMA(1, 1, At, B1); PG8_BAR;
        }
        PG8_STAMP();
        if constexpr (!Epi::AFTER_DRAIN) { E(acc, cur, wr, wc, fr, fq); S.done(cur); }
        PG8_STAMP();
        if (!has_next) break;
#pragma unroll
        for (int a = 0; a < 2; ++a)
#pragma unroll
            for (int b = 0; b < 2; ++b)
#pragma unroll
                for (int m = 0; m < 4; ++m)
#pragma unroll
                    for (int n = 0; n < 2; ++n) acc[a][b][m][n] = (f32x4){0.f, 0.f, 0.f, 0.f};
        cur = nxt; cA = nA; cB = nB; ++ui;
        if constexpr (GATHER) { _Pragma("unroll") for (int _h = 0; _h < 2; ++_h) _Pragma("unroll") for (int _i = 0; _i < 2; ++_i) vgC[_h][_i] = vgN[_h][_i]; }
    }
    PG8_WAIT_V(0);
    if (wr == 0) PG8_BAR;
    PG8_BAR;
    if constexpr (Epi::AFTER_DRAIN) { E.fused(acc, cur, wr, wc, fr, fq, lds, wid, lane); S.done(cur); }
    PG8_STAMP();
    if (STAMP && wid == 0) { stamps[lane] = lane < nts ? (((unsigned long long)(unsigned)ts_hi << 32) | (unsigned)ts_lo) : 0ull;
        if (lane == 62) stamps[62] = rt_entry; if (lane == 63) stamps[63] = (unsigned long long)wall_clock64(); }
#undef PG8_STAMP
#undef PG8_SA
#undef PG8_SB
#undef PG8_STAGE
#undef PG8_STAGE_A
#undef PG8_GOFF
#undef PG8_LDA
#undef PG8_LDB
#undef PG8_MMA
#undef PG8_WAIT_V
#undef PG8_WAIT_L
#undef PG8_BAR
#undef PG8_SCHED
}
}
#ifndef STOP_AFTER
#define STOP_AFTER 99
#endif
#ifndef PH_MASK
#define PH_MASK 0xffffffffu
#endif
#define PH(k) ((PH_MASK >> (k)) & 1u)
#ifndef REP_MASK
#define REP_MASK 0u
#endif
#ifndef XBARS
#define XBARS 0
#endif
#ifndef TPMASK
#define TPMASK 0ull
#endif
#define TSEL(k) ((TPMASK >> (k)) & 1ull)
#define PSTART(k) do { if (TSEL(k) && blockIdx.x == 0 && threadIdx.x == 0) { ((volatile LAS unsigned long long*)(F.lds + MISC_OFF + 64))[0] = wall_clock64(); } } while (0)
#define PEND(k) do { if (TSEL(k) && blockIdx.x == 0 && threadIdx.x == 0) { volatile LAS unsigned long long* tp_ = (volatile LAS unsigned long long*)(F.lds + MISC_OFF + 64); tp_[1] += wall_clock64() - tp_[0]; } } while (0)
#define PFINAL() do { if (TPMASK != 0ull && blockIdx.x == 0 && threadIdx.x == 0) { const unsigned long long d_ = 4ull * ((volatile LAS unsigned long long*)(F.lds + MISC_OFF + 64))[1], t_ = wall_clock64(); while (wall_clock64() - t_ < d_) __builtin_amdgcn_s_sleep(8); } } while (0)
#define REPCNT(k) (((REP_MASK >> (k)) & 1u) ? 2 : 1)
#define RUNREP(k, stmt) do { stmt; if (REPCNT(k) == 2) { xcd_barrier(bar); stmt; } } while (0)
constexpr int NT = 16384, DM = 1024, NB = 8, SL = 2048;
constexpr int NWAVES = 8;
constexpr float RMS_EPS = 1e-6f;
constexpr size_t MiB = 1u << 20;
constexpr size_t WS_CTL = 0, CTL_ZERO_BYTES = 1 * MiB;
constexpr size_t WS_WIN = 1 * MiB;
constexpr size_t WS_GLU = 4 * MiB;
constexpr size_t WS_WOUT = WS_GLU + MiB / 2;
constexpr size_t WS_MIN = WS_WOUT + 2 * MiB;
constexpr size_t WS_UQ = 8 * MiB;
constexpr size_t WS_UK = WS_UQ + 5 * MiB / 4;
constexpr size_t WS_UV = WS_UK + MiB / 2;
constexpr size_t WS_WO = WS_UV + MiB / 2;
constexpr size_t WS_WR = WS_WO + 2 * MiB;
constexpr size_t WS_W13 = 13 * MiB;
constexpr size_t WS_W2 = 77 * MiB;
constexpr size_t WS_X2 = 109 * MiB;
constexpr size_t WS_XN = 173 * MiB;
constexpr size_t WS_AR = 205 * MiB;
constexpr size_t WS_END = WS_AR + 254 * MiB;
static_assert(WS_WR + 2 * 96 * 1024 * 2 <= WS_W13, "ws map");
constexpr size_t AR_PROJ = WS_AR, AR_YAPRE = WS_AR + 48 * MiB, AR_YCAT = WS_AR + 64 * MiB;
constexpr size_t AR_LRUC = WS_AR + 96 * MiB;
constexpr size_t AR_S5T = WS_AR + 98 * MiB;
constexpr size_t AR_WAF = WS_AR + 97 * MiB;
constexpr size_t AR_SLOT = WS_AR  , AR_H = WS_AR + 96 * MiB, AR_YDISP = WS_AR + 120 * MiB, AR_TOK = WS_AR + 216 * MiB;
constexpr int MAX_RT = 192, SLOT_CAP = 16384;
constexpr size_t AR_CQR = WS_AR, AR_CKVR = WS_AR + 12 * MiB, AR_KRR = WS_AR + 20 * MiB, AR_COS = WS_AR + 22 * MiB, AR_SIN = WS_AR + 24 * MiB,
                 AR_CQ = WS_AR + 26 * MiB, AR_CKV = WS_AR + 38 * MiB, AR_QRAW = WS_AR + 46 * MiB, AR_KNRAW = WS_AR + 94 * MiB, AR_VT = WS_AR + 126 * MiB,
                 AR_QF = WS_AR + 158 * MiB, AR_KF = WS_AR + 206 * MiB, AR_O = AR_QRAW;
constexpr int CW_BAR = 4096, CW_CNT = 8192;
constexpr int RING_BYTES = 131072;
constexpr int WSCR = 17408;
constexpr int EX_OFF = 8 * WSCR;
constexpr int TAB_OFF = EX_OFF + 4096;
constexpr int MISC_OFF = TAB_OFF + 1408;
constexpr int LDS_BYTES = 147456;
static_assert(MISC_OFF + 128 <= LDS_BYTES, "LDS map");

#define GAS __attribute__((address_space(1)))
#define LAS __attribute__((address_space(3)))
typedef unsigned short bf16;
typedef unsigned v4u __attribute__((ext_vector_type(4)));
typedef unsigned v2u __attribute__((ext_vector_type(2)));
typedef float f32x4 __attribute__((ext_vector_type(4)));
typedef float f32x16 __attribute__((ext_vector_type(16)));
typedef short bf16x8 __attribute__((ext_vector_type(8)));
typedef GAS unsigned gu32;
#define RLX_AGENT __ATOMIC_RELAXED, __HIP_MEMORY_SCOPE_AGENT
#define LDS_WAIT() asm volatile("s_waitcnt lgkmcnt(0)" ::: "memory")
#define VM_WAIT() asm volatile("s_waitcnt vmcnt(0)" ::: "memory")
#define CBAR() asm volatile("" ::: "memory")
__device__ __forceinline__ unsigned pk2(float lo, float hi) { unsigned r; asm("v_cvt_pk_bf16_f32 %0, %1, %2" : "=v"(r) : "v"(lo), "v"(hi)); return r; }
__device__ __forceinline__ unsigned f2bf(float f) { return pk2(f, 0.f) & 0xffffu; }
__device__ __forceinline__ float bf2f(unsigned b16) { return __uint_as_float(b16 << 16); }
__device__ __forceinline__ float bflo(unsigned w) { return __uint_as_float(w << 16); }
__device__ __forceinline__ float bfhi(unsigned w) { return __uint_as_float(w & 0xffff0000u); }
__device__ __forceinline__ float sigm(float x) { return 1.0f / (1.0f + __expf(-x)); }
__device__ __forceinline__ float gelu_tanh(float x) { const float z = 0.7978845608028654f * (x + 0.044715f * x * x * x); const float t = 1.0f - 2.0f / (1.0f + __expf(2.0f * z)); return 0.5f * x * (1.0f + t); }
__device__ __forceinline__ float wave_sum(float v) {
#pragma unroll
    for (int o = 1; o < 64; o <<= 1) v += __shfl_xor(v, o);
    return v;
}
__device__ __forceinline__ int crow(int r, int hi) { return (r & 3) + 8 * (r >> 2) + 4 * hi; }

#define XB_TMO      128
#define XB_XCNT(j)  (256  + 64 * (j))
#define XB_XSUB(j)  (1280 + 64 * (j))
#define XB_XGEN(j)  (2304 + 64 * (j))
#define XB_TOP      3328
#define XB_TOPGEN   3392
#define XCD_BAR_WORDS 3456
#define XB_SPIN_CAP (1u << 18)
__device__ __forceinline__ unsigned xb_ld(unsigned* p)              { return __hip_atomic_load(p, __ATOMIC_RELAXED, __HIP_MEMORY_SCOPE_AGENT); }
__device__ __forceinline__ unsigned xb_add(unsigned* p, unsigned v) { return __hip_atomic_fetch_add(p, v, __ATOMIC_RELAXED, __HIP_MEMORY_SCOPE_AGENT); }
__device__ __forceinline__ unsigned xb_xcc_id() { return (unsigned)__builtin_amdgcn_s_getreg((3 << 11) | 20) & 0xFu; }
#define XB_SPIN(cond, bar) do { unsigned _sp = 0; while (cond) { __builtin_amdgcn_s_sleep(1); \
    if ((++_sp & 255u) == 0u) { if (xb_ld(&(bar)[XB_TMO])) break; if (_sp > XB_SPIN_CAP) { atomicAdd(&(bar)[XB_TMO], 1u); break; } } } } while (0)
struct XcdBarrier { unsigned* bar; unsigned x; volatile LAS unsigned* st; };
__device__ __forceinline__ XcdBarrier xcd_barrier_post(unsigned* bar, volatile LAS unsigned* st) {
    XcdBarrier b; b.bar = bar; b.x = xb_xcc_id(); b.st = st;
    if (threadIdx.x == 0) (void)xb_add(&bar[XB_XCNT(b.x)], 1u);
    return b;
}
__device__ __forceinline__ void xcd_barrier_complete(unsigned* bar, unsigned x, unsigned& nloc, unsigned& nx) {
    const unsigned G = gridDim.x * gridDim.y * gridDim.z;
    unsigned sum, cnt, mine, sp = 0u;
    for (;;) {
        sum = 0u; cnt = 0u; mine = 0u;
#pragma unroll
        for (unsigned j = 0; j < 16; ++j) { const unsigned c = xb_ld(&bar[XB_XCNT(j)]); sum += c; cnt += (c > 0u) ? 1u : 0u; mine = (j == x) ? c : mine; }
        if (sum == G) break;
        __builtin_amdgcn_s_sleep(1);
        if ((++sp & 255u) == 0u) { if (xb_ld(&bar[XB_TMO])) break; if (sp > XB_SPIN_CAP) { atomicAdd(&bar[XB_TMO], 1u); break; } }
    }
    nloc = mine > 0u ? mine : 1u; nx = cnt > 0u ? cnt : 1u;
}
__device__ __forceinline__ void xcd_barrier(const XcdBarrier& b) {
    asm volatile("s_waitcnt vmcnt(0)" ::: "memory");
    __syncthreads();
    if (threadIdx.x == 0) {
        unsigned* bar = b.bar;
        __builtin_amdgcn_s_waitcnt(0);
        unsigned nloc = b.st[0], nx = b.st[1];
        if (nloc == 0u) { xcd_barrier_complete(bar, b.x, nloc, nx); b.st[0] = nloc; b.st[1] = nx; }
        const unsigned old = xb_add(&bar[XB_XSUB(b.x)], 1u);
        const unsigned gen = old / nloc;
        if (old + 1u == (gen + 1u) * nloc) {
            __builtin_amdgcn_fence(__ATOMIC_RELEASE, "agent");
            asm volatile("s_waitcnt vmcnt(0)" ::: "memory");
            const unsigned og = xb_add(&bar[XB_TOP], 1u);
            const unsigned tg = og / nx;
            if (og + 1u == (tg + 1u) * nx) xb_add(&bar[XB_TOPGEN], 1u);
            else XB_SPIN(xb_ld(&bar[XB_TOPGEN]) == tg, bar);
            __builtin_amdgcn_fence(__ATOMIC_ACQUIRE, "agent");
            xb_add(&bar[XB_XGEN(b.x)], 1u);
            asm volatile("s_waitcnt vmcnt(0)" ::: "memory");
        } else {
            XB_SPIN(xb_ld(&bar[XB_XGEN(b.x)]) == gen, bar);
            __builtin_amdgcn_fence(__ATOMIC_ACQUIRE, "agent");
            asm volatile("s_waitcnt vmcnt(0)" ::: "memory");
        }
    }
    __syncthreads();
}

struct Args { const float* in[39]; const int* pos; float* out; unsigned char* ws; };
struct Frame {
    LAS unsigned char* lds;
    int tid, lane, wave, vcu, G, gw, ngw;
};

__device__ __forceinline__ void tr_item(const float* W, int N, int k0, int n0, bf16* dst, int ldk, LAS float* scr, int lane) {
#pragma unroll 8
    for (int i = 0; i < 32; ++i) { const int kk = 2 * i + (lane >> 5); scr[kk * 33 + (lane & 31)] = W[(size_t)(k0 + kk) * N + n0 + (lane & 31)]; }
    LDS_WAIT(); CBAR();
    const int c = lane & 7;
#pragma unroll
    for (int j = 0; j < 4; ++j) { const int n = (lane >> 3) + 8 * j; const LAS float* s = scr + (8 * c) * 33 + n;
        v4u o; o.x = pk2(s[0 * 33], s[1 * 33]); o.y = pk2(s[2 * 33], s[3 * 33]); o.z = pk2(s[4 * 33], s[5 * 33]); o.w = pk2(s[6 * 33], s[7 * 33]);
        *(v4u*)(dst + (size_t)n * ldk + k0 + 8 * c) = o; }
    LDS_WAIT(); CBAR();
}
__device__ __forceinline__ void tr_plain(const float* W, int K, int N, bf16* WT, int item, LAS float* scr, int lane) {
    const int nblk = N / 32, kb = item / nblk, nb = item % nblk;
    tr_item(W, N, 64 * kb, 32 * nb, WT + (size_t)(32 * nb) * K, K, scr, lane);
}
__device__ __forceinline__ void conv_moe(const Frame& F, const Args& a, int layer, LAS float* scr) {
    bf16* W13T = (bf16*)(a.ws + WS_W13); bf16* W2T = (bf16*)(a.ws + WS_W2);
    for (int it = F.gw; it < 3 * 8192; it += F.ngw) {
        const int type = it >> 13, r = it & 8191, e = r >> 7, q = r & 127;
        if (type < 2) {
            const float* W = a.in[type == 0 ? 36 : 37] + (size_t)(layer * 64 + e) * 1024 * 256;
            const int kb = q >> 3, nb = q & 7, n0 = 32 * nb;
            const int drow = e * 512 + (n0 >> 7) * 256 + (type == 1 ? 128 : 0) + (n0 & 127);
            tr_item(W, 256, 64 * kb, n0, W13T + (size_t)drow * 1024, 1024, scr, F.lane);
        } else {
            const float* W = a.in[38] + (size_t)(layer * 64 + e) * 256 * 1024;
            const int kb = q >> 5, nb = q & 31, n0 = 32 * nb;
            tr_item(W, 1024, 64 * kb, n0, W2T + (size_t)(e * 1024 + n0) * 256, 256, scr, F.lane);
        }
    }
}
__device__ __forceinline__ void norm_row(const f32x4 (&v)[4], const f32x4 (&g)[4], bf16* orow, int lane) {
    float s = 0.f;
#pragma unroll
    for (int j = 0; j < 4; ++j) s += (v[j].x * v[j].x + v[j].y * v[j].y) + (v[j].z * v[j].z + v[j].w * v[j].w);
    const float rs = rsqrtf(wave_sum(s) * (1.f / DM) + RMS_EPS);
    v2u* o8 = (v2u*)orow + lane;
#pragma unroll
    for (int j = 0; j < 4; ++j) { v2u w; w.x = pk2(v[j].x * rs * g[j].x, v[j].y * rs * g[j].y); w.y = pk2(v[j].z * rs * g[j].z, v[j].w * rs * g[j].w); o8[64 * j] = w; }
}

constexpr int CV_STEPS = 3 * 64 * 256, CV_PER_WAVE = CV_STEPS / 2048;
struct CvAddr { const float* src; bf16* dst; int ldn, ldk; };
__device__ __forceinline__ CvAddr cv_decode(const Args& a, int layer, int idx, int lane) {
    const int type = idx >> 14, r = idx & 16383, e = r >> 8, q = r & 255, kb = lane & 7, nb = lane >> 3;
    CvAddr c;
    if (type < 2) { const int k0 = 32 * (q >> 3) + 4 * kb, n = 32 * (q & 7) + 4 * nb;
        c.src = a.in[type == 0 ? 36 : 37] + (size_t)(layer * 64 + e) * 1024 * 256 + (size_t)k0 * 256 + n; c.ldn = 256; c.ldk = 1024;
        c.dst = (bf16*)(a.ws + WS_W13) + (size_t)(e * 512 + (n >> 7) * 256 + (type == 1 ? 128 : 0) + (n & 127)) * 1024 + k0; }
    else { const int k0 = 32 * (q >> 5) + 4 * kb, n = 32 * (q & 31) + 4 * nb;
        c.src = a.in[38] + (size_t)(layer * 64 + e) * 256 * 1024 + (size_t)k0 * 1024 + n; c.ldn = 1024; c.ldk = 256;
        c.dst = (bf16*)(a.ws + WS_W2) + (size_t)(e * 1024 + n) * 256 + k0; }
    return c;
}
struct CvPipe { f32x4 x[4]; bf16* dst; int ldk; bool pending; };
__device__ __forceinline__ void cv_step(const Args& a, int layer, int idx, bool more, int lane, CvPipe& p) {
    if (p.pending) {
#pragma unroll
        for (int j = 0; j < 4; ++j) { v2u o; o.x = pk2(p.x[0][j], p.x[1][j]); o.y = pk2(p.x[2][j], p.x[3][j]); __builtin_nontemporal_store(o, (v2u*)(p.dst + (size_t)j * p.ldk)); }
    }
    p.pending = more;
    if (more) { const CvAddr c = cv_decode(a, layer, idx, lane); p.dst = c.dst; p.ldk = c.ldk;
#pragma unroll
        for (int r = 0; r < 4; ++r) p.x[r] = __builtin_nontemporal_load((const f32x4*)(c.src + (size_t)r * c.ldn)); }
}
__device__ __forceinline__ void cv_issue(const Args& a, int layer, int idx, int lane, f32x4 (&x)[4]) {
    const CvAddr c = cv_decode(a, layer, idx, lane);
#pragma unroll
    for (int r = 0; r < 4; ++r) x[r] = *(const f32x4*)(c.src + (size_t)r * c.ldn);
}
__device__ __forceinline__ void cv_finish(const Args& a, int layer, int idx, int lane, const f32x4 (&x)[4]) {
    const CvAddr c = cv_decode(a, layer, idx, lane);
#pragma unroll
    for (int j = 0; j < 4; ++j) { v2u o; o.x = pk2(x[0][j], x[1][j]); o.y = pk2(x[2][j], x[3][j]); *(v2u*)(c.dst + (size_t)j * c.ldk) = o; }
}
__device__ __forceinline__ void s5_build_table(const Args& a, int g, int lane);
__device__ __forceinline__ void p0_prologue(const Frame& F, const Args& a) {
    LAS float* scr = (LAS float*)(F.lds + F.wave * WSCR);
    unsigned char* ws = a.ws;
    for (int it = F.gw; it < 2816; it += F.ngw) {
        int r = it;
        if (r < 768) { tr_plain(a.in[3], 1024, 1536, (bf16*)(ws + WS_WIN), r, scr, F.lane); continue; } r -= 768;
        if (r < 128) { tr_plain(a.in[12], 512, 512, (bf16*)(ws + WS_GLU), r, scr, F.lane); continue; } r -= 128;
        if (r < 512) { tr_plain(a.in[21], 1024, 1024, (bf16*)(ws + WS_WOUT), r, scr, F.lane); continue; } r -= 512;
        if (r < 352) { tr_plain(a.in[23], 1024, 704, (bf16*)(ws + WS_MIN), r, scr, F.lane); continue; } r -= 352;
        if (r < 288) { tr_plain(a.in[26], 384, 1536, (bf16*)(ws + WS_UQ), r, scr, F.lane); continue; } r -= 288;
        if (r < 256) {
            const int kb = r / 64, nb = r % 64, n0 = 32 * nb, h = n0 >> 8, rr = n0 & 255;
            bf16* dst = (rr < 128) ? (bf16*)(ws + WS_UK) + (size_t)(h * 128 + rr) * 256 : (bf16*)(ws + WS_UV) + (size_t)(h * 128 + rr - 128) * 256;
            tr_item(a.in[27], 2048, 64 * kb, n0, dst, 256, scr, F.lane); continue; } r -= 256;
        tr_plain(a.in[30], 1024, 1024, (bf16*)(ws + WS_WO), r, scr, F.lane);
    }
    { v4u* z = (v4u*)((bf16*)(ws + WS_MIN) + (size_t)704 * 1024); const int n16 = 64 * 1024 * 2 / 16;
      for (int i = F.gw * 64 + F.lane; i < n16; i += F.ngw * 64) z[i] = (v4u){0u, 0u, 0u, 0u}; }
    { bf16* wr = (bf16*)(ws + WS_WR);
      for (int i = F.gw * 64 + F.lane; i < 2 * 96 * 1024; i += F.ngw * 64) {
          const int layer = i / (96 * 1024), rem = i % (96 * 1024), r = rem >> 10, k = rem & 1023;
          float v = 0.f;
          if (r < 8) v = a.in[32][(size_t)(layer * 1024 + k) * 8 + r];
          else if (r < 72) v = a.in[34][(size_t)(layer * 1024 + k) * 64 + (r - 8)];
          wr[i] = (bf16)f2bf(v); } }
    { v4u* waf = (v4u*)(ws + AR_WAF);
      for (int i = F.gw * 64 + F.lane; i < 8192; i += F.ngw * 64) {
          const int ln = i & 63, sx = (i >> 6) & 3, blk = (i >> 8) & 1, gate = (i >> 9) & 1, n = i >> 10;
          const float* W = a.in[gate ? 18 : 16] + (size_t)n * 64 * 64; const int d = (ln & 31) + 32 * blk, c0 = 16 * sx + 8 * (ln >> 5);
          float v[8];
#pragma unroll
          for (int j = 0; j < 8; ++j) v[j] = W[(c0 + j) * 64 + d];
          v4u o; o.x = pk2(v[0], v[1]); o.y = pk2(v[2], v[3]); o.z = pk2(v[4], v[5]); o.w = pk2(v[6], v[7]); waf[i] = o; } }
    for (int g = F.gw; g < 32; g += F.ngw) s5_build_table(a, g, F.lane);
    { const float* x = a.in[0]; const float* gn = a.in[2]; bf16* XN = (bf16*)(ws + WS_XN);
      f32x4 g[4];
#pragma unroll
      for (int j = 0; j < 4; ++j) g[j] = *((const f32x4*)gn + F.lane + 64 * j);
      for (int m = F.gw; m < NT; m += F.ngw) { f32x4 v[4]; const f32x4* xr = (const f32x4*)(x + (size_t)m * DM) + F.lane;
#pragma unroll
          for (int j = 0; j < 4; ++j) v[j] = xr[64 * j];
          norm_row(v, g, XN + (size_t)m * DM, F.lane); } }
}

__device__ __forceinline__ void cmul_acc(float& sr, float& si, float ar, float ai, float br, float bi) { const float nr = fmaf(ar, sr, fmaf(-ai, si, br)), ni = fmaf(ar, si, fmaf(ai, sr, bi)); sr = nr; si = ni; }
constexpr int S5T_BYTES = 512 + 4096 + 4096;
__device__ __forceinline__ void s5_build_table(const Args& a, int g, int lane) {
    const int r32 = lane & 31, hh = lane >> 5;
    unsigned char* tabg = a.ws + AR_S5T + (size_t)g * S5T_BYTES;
    const float* lam_re = a.in[4] + g * 64; const float* lam_im = a.in[5] + g * 64; const float dt = expf(a.in[6][g]);
    const float* b_re = a.in[7] + (size_t)g * 64 * 16; const float* b_im = a.in[8] + (size_t)g * 64 * 16;
    const float* c_re = a.in[9] + (size_t)g * 16 * 64; const float* c_im = a.in[10] + (size_t)g * 16 * 64;
    float lbr, lbi;
    { const float lr = fminf(lam_re[lane], -1e-4f), li = lam_im[lane]; const float mag = expf(lr * dt); lbr = mag * cosf(li * dt); lbi = mag * sinf(li * dt); }
    bf16x8 af[4];
#pragma unroll
    for (int pb = 0; pb < 2; ++pb) {
        const int p = r32 + 32 * pb;
        const float lr = fminf(lam_re[p], -1e-4f), li = lam_im[p]; const float mag = expf(lr * dt); const float pr = mag * cosf(li * dt), pi = mag * sinf(li * dt);
        const float den = lr * lr + li * li, nr = pr - 1.0f; const float fr_ = (nr * lr + pi * li) / den, fi_ = (pi * lr - nr * li) / den;
        const f32x4 br0 = *(const f32x4*)(b_re + p * 16 + 8 * hh), br1 = *(const f32x4*)(b_re + p * 16 + 8 * hh + 4);
        const f32x4 bi0 = *(const f32x4*)(b_im + p * 16 + 8 * hh), bi1 = *(const f32x4*)(b_im + p * 16 + 8 * hh + 4);
        v4u wre, wim;
        wre.x = pk2(fr_ * br0.x - fi_ * bi0.x, fr_ * br0.y - fi_ * bi0.y); wre.y = pk2(fr_ * br0.z - fi_ * bi0.z, fr_ * br0.w - fi_ * bi0.w);
        wre.z = pk2(fr_ * br1.x - fi_ * bi1.x, fr_ * br1.y - fi_ * bi1.y); wre.w = pk2(fr_ * br1.z - fi_ * bi1.z, fr_ * br1.w - fi_ * bi1.w);
        wim.x = pk2(fr_ * bi0.x + fi_ * br0.x, fr_ * bi0.y + fi_ * br0.y); wim.y = pk2(fr_ * bi0.z + fi_ * br0.z, fr_ * bi0.w + fi_ * br0.w);
        wim.z = pk2(fr_ * bi1.x + fi_ * br1.x, fr_ * bi1.y + fi_ * br1.y); wim.w = pk2(fr_ * bi1.z + fi_ * br1.z, fr_ * bi1.w + fi_ * br1.w);
        af[pb] = __builtin_bit_cast(bf16x8, wre); af[2 + pb] = __builtin_bit_cast(bf16x8, wim);
    }
    const int h16 = lane & 15, kq = lane >> 4;
    bf16x8 cf[4];
#pragma unroll
    for (int ks = 0; ks < 4; ++ks) {
        const int k = 32 * ks + 8 * kq; const float* src = (k < 64) ? (c_re + h16 * 64 + k) : (c_im + h16 * 64 + (k - 64)); const float sg = (k < 64) ? 1.f : -1.f;
        const f32x4 c0 = *(const f32x4*)src, c1 = *(const f32x4*)(src + 4);
        v4u wv; wv.x = pk2(sg * c0.x, sg * c0.y); wv.y = pk2(sg * c0.z, sg * c0.w); wv.z = pk2(sg * c1.x, sg * c1.y); wv.w = pk2(sg * c1.z, sg * c1.w);
        cf[ks] = __builtin_bit_cast(bf16x8, wv);
    }
    ((float*)tabg)[lane] = lbr; ((float*)tabg)[64 + lane] = lbi;
#pragma unroll
    for (int i = 0; i < 4; ++i) { *(bf16x8*)(tabg + 512 + (i * 64 + lane) * 16) = af[i]; *(bf16x8*)(tabg + 512 + 4096 + (i * 64 + lane) * 16) = cf[i]; }
}
__device__ __forceinline__ void s5_unit(const Frame& F, const Args& a, int b, int g) {
    const int lane = F.lane, w = F.wave, r32 = lane & 31, hh = lane >> 5;
    LAS float* BU = (LAS float*)(F.lds + w * WSCR);
    LAS float* EX = (LAS float*)(F.lds + EX_OFF);
    const bf16* PROJ = (const bf16*)(a.ws + AR_PROJ); bf16* YAPRE = (bf16*)(a.ws + AR_YAPRE);
    const float* dvec = a.in[11] + g * 16;
    const unsigned char* tabg = a.ws + AR_S5T + (size_t)g * S5T_BYTES;
    const float lbr = ((const float*)tabg)[lane], lbi = ((const float*)tabg)[64 + lane];
    bf16x8 af[4], cf[4];
#pragma unroll
    for (int i = 0; i < 4; ++i) { af[i] = *(const bf16x8*)(tabg + 512 + (i * 64 + lane) * 16); cf[i] = *(const bf16x8*)(tabg + 512 + 4096 + (i * 64 + lane) * 16); }
    const int h16 = lane & 15, kq = lane >> 4;
    const f32x4 dv = *(const f32x4*)(dvec + 4 * kq);
    const size_t tbase = (size_t)b * SL + (size_t)w * 256;
    float sr = 0.f, si = 0.f;
    CvPipe cvp0, cvp1; cvp0.pending = false; cvp1.pending = false; cvp0.dst = nullptr; cvp1.dst = nullptr; cvp0.ldk = 0; cvp1.ldk = 0;
#pragma unroll 1
    for (int pass = 0; pass < 2; ++pass) {
        if (pass == 1) {

            EX[w * 128 + lane] = sr; EX[w * 128 + 64 + lane] = si;
            LDS_WAIT(); __syncthreads();
            float pr = lbr, pi = lbi;
#pragma unroll
            for (int q = 0; q < 8; ++q) { const float nr = pr * pr - pi * pi, ni = 2.f * pr * pi; pr = nr; pi = ni; }
            sr = 0.f; si = 0.f;
            for (int wp = 0; wp < w; ++wp) cmul_acc(sr, si, pr, pi, EX[wp * 128 + lane], EX[wp * 128 + 64 + lane]);
        }
        bf16x8 ufn = *(const bf16x8*)(PROJ + (tbase + r32) * 1536 + g * 16 + 8 * hh);
#pragma unroll 1
        for (int sb = 0; sb < 8; ++sb) {
            const size_t t0 = tbase + sb * 32;
            const bf16x8 uf = ufn;
            if (sb + 1 < 8) ufn = *(const bf16x8*)(PROJ + (t0 + 32 + r32) * 1536 + g * 16 + 8 * hh);
            { const int cvk = (pass == 0) ? 2 * sb : 16 + sb; cv_step(a, 0, F.gw + cvk * F.ngw, true, lane, cvp0); cv_step(a, 0, F.gw + (cvk + 1) * F.ngw, pass == 0, lane, cvp1); }
            v2u uu2[2] = {{0u, 0u}, {0u, 0u}};
            if (pass == 1) { uu2[0] = *(const v2u*)(PROJ + (t0 + h16) * 1536 + g * 16 + 4 * kq); uu2[1] = *(const v2u*)(PROJ + (t0 + 16 + h16) * 1536 + g * 16 + 4 * kq); }
#pragma unroll
            for (int blk = 0; blk < 4; ++blk) {
                f32x16 acc = {};
                acc = __builtin_amdgcn_mfma_f32_32x32x16_bf16(af[blk], uf, acc, 0, 0, 0);
#pragma unroll
                for (int q = 0; q < 4; ++q) *(LAS f32x4*)(BU + r32 * 132 + 32 * blk + 8 * q + 4 * hh) = (f32x4){acc[4 * q], acc[4 * q + 1], acc[4 * q + 2], acc[4 * q + 3]};
            }
            LDS_WAIT(); CBAR();
            if (pass == 0) {
#pragma unroll 8
                for (int t = 0; t < 32; ++t) cmul_acc(sr, si, lbr, lbi, BU[t * 132 + lane], BU[t * 132 + 64 + lane]);
            } else {
#pragma unroll 8
                for (int t = 0; t < 32; ++t) { cmul_acc(sr, si, lbr, lbi, BU[t * 132 + lane], BU[t * 132 + 64 + lane]); BU[t * 132 + lane] = sr; BU[t * 132 + 64 + lane] = si; }
                LDS_WAIT(); CBAR();
#pragma unroll
                for (int tb = 0; tb < 2; ++tb) {
                    f32x4 y = {0.f, 0.f, 0.f, 0.f};
#pragma unroll
                    for (int ks = 0; ks < 4; ++ks) {
                        const LAS float* sp = BU + (16 * tb + h16) * 132 + 32 * ks + 8 * kq;
                        const f32x4 s0 = *(const LAS f32x4*)sp, s1 = *(const LAS f32x4*)(sp + 4);
                        v4u wv; wv.x = pk2(s0.x, s0.y); wv.y = pk2(s0.z, s0.w); wv.z = pk2(s1.x, s1.y); wv.w = pk2(s1.z, s1.w);
                        y = __builtin_amdgcn_mfma_f32_16x16x32_bf16(cf[ks], __builtin_bit_cast(bf16x8, wv), y, 0, 0, 0);
                    }
                    const size_t t = t0 + 16 * tb + h16;
                    const v2u uu = uu2[tb];
                    const float y0 = gelu_tanh(y[0] + dv.x * bflo(uu.x)), y1 = gelu_tanh(y[1] + dv.y * bfhi(uu.x)), y2 = gelu_tanh(y[2] + dv.z * bflo(uu.y)), y3 = gelu_tanh(y[3] + dv.w * bfhi(uu.y));
                    v2u o; o.x = pk2(y0, y1); o.y = pk2(y2, y3);
                    *(v2u*)(YAPRE + t * 512 + g * 16 + 4 * kq) = o;
                }
                LDS_WAIT(); CBAR();
            }
        }
    }
    cv_step(a, 0, 0, false, lane, cvp0); cv_step(a, 0, 0, false, lane, cvp1);
    __syncthreads();
}
template <int PASS>
__device__ __forceinline__ void lru_chunk(const Frame& F, const Args& a, int b, int n, int q) {
    const int lane = F.lane, w = F.wave, r32 = lane & 31, hh = lane >> 5, ch = n * 64 + lane, ci = 8 * q + w;
    LAS unsigned char* scrb = F.lds + w * WSCR;
    LAS bf16* XF = (LAS bf16*)scrb;
    LAS float* GA = (LAS float*)scrb;
    LAS float* GI = (LAS float*)(scrb + 32 * 68 * 4);
    const bf16* PROJ = (const bf16*)(a.ws + AR_PROJ); bf16* YCAT = (bf16*)(a.ws + AR_YCAT);
    float* CA = (float*)(a.ws + AR_LRUC) + (size_t)((b * 8 + n) * 32) * 64; float* CH = CA + 8 * 8 * 32 * 64;
    const float L2E = 1.4426950408889634f;
    const float cw0 = a.in[14][0 * 512 + ch], cw1 = a.in[14][1 * 512 + ch], cw2 = a.in[14][2 * 512 + ch], cw3 = a.in[14][3 * 512 + ch], cb = a.in[15][ch];
    const float ba = -L2E * a.in[17][ch], bi = -L2E * a.in[19][ch];
    const float lsl8 = -8.0f * L2E * log1pf(expf(-a.in[20][ch]));
    float hst = 0.f, aprod = 1.f;
    if (PASS == 1) {
#pragma unroll 1
        for (int c0 = 0; c0 < ci; c0 += 8) {
            float ca[8], chh[8];
#pragma unroll
            for (int j = 0; j < 8; ++j) { const bool on = c0 + j < ci; ca[j] = on ? CA[(c0 + j) * 64 + lane] : 1.f; chh[j] = on ? CH[(c0 + j) * 64 + lane] : 0.f; }
#pragma unroll
            for (int j = 0; j < 8; ++j) hst = fmaf(ca[j], hst, chh[j]);
        }
    }
    CBAR(); __builtin_amdgcn_sched_barrier(0);
    bf16x8 fa[2][4], fi[2][4];
    { const bf16x8* wf = (const bf16x8*)(a.ws + AR_WAF) + (size_t)n * 2 * 2 * 4 * 64 + lane;
#pragma unroll
      for (int blk = 0; blk < 2; ++blk)
#pragma unroll
          for (int s = 0; s < 4; ++s) { fa[blk][s] = wf[((0 * 2 + blk) * 4 + s) * 64]; fi[blk][s] = wf[((1 * 2 + blk) * 4 + s) * 64]; } }
    const int l0 = ci * 64; const size_t tbase = (size_t)b * SL + l0;
    float xm3 = 0.f, xm2 = 0.f, xm1 = 0.f;
    if (l0 > 0) { xm3 = bf2f(PROJ[(tbase - 3) * 1536 + 512 + ch]); xm2 = bf2f(PROJ[(tbase - 2) * 1536 + 512 + ch]); xm1 = bf2f(PROJ[(tbase - 1) * 1536 + 512 + ch]); }
#pragma unroll 1
    for (int sb = 0; sb < 2; ++sb) {
        const size_t t0 = tbase + sb * 32;
        float xf[32]; unsigned short glr[32];
#pragma unroll
        for (int t = 0; t < 32; ++t) xf[t] = bf2f(PROJ[(t0 + t) * 1536 + 512 + ch]);
#pragma unroll
        for (int t = 0; t < 32; ++t) { const float xc = xf[t];
            xf[t] = cw0 * xm3 + cw1 * xm2 + cw2 * xm1 + cw3 * xc + cb; xm3 = xm2; xm2 = xm1; xm1 = xc;
            XF[t * 72 + lane] = (bf16)f2bf(xf[t]); }
        LDS_WAIT(); CBAR();
        bf16x8 xb[4];
#pragma unroll
        for (int s = 0; s < 4; ++s) xb[s] = *(const LAS bf16x8*)(XF + r32 * 72 + 16 * s + 8 * hh);
        LDS_WAIT(); CBAR();
#pragma unroll
        for (int blk = 0; blk < 2; ++blk) {
            f32x16 ga = {}, gi = {};
#pragma unroll
            for (int s = 0; s < 4; ++s) { ga = __builtin_amdgcn_mfma_f32_32x32x16_bf16(fa[blk][s], xb[s], ga, 0, 0, 0); gi = __builtin_amdgcn_mfma_f32_32x32x16_bf16(fi[blk][s], xb[s], gi, 0, 0, 0); }
#pragma unroll
            for (int qq = 0; qq < 4; ++qq) { *(LAS f32x4*)(GA + r32 * 68 + 32 * blk + 8 * qq + 4 * hh) = (f32x4){ga[4 * qq], ga[4 * qq + 1], ga[4 * qq + 2], ga[4 * qq + 3]};
                                             *(LAS f32x4*)(GI + r32 * 68 + 32 * blk + 8 * qq + 4 * hh) = (f32x4){gi[4 * qq], gi[4 * qq + 1], gi[4 * qq + 2], gi[4 * qq + 3]}; }
        }
        if (PASS == 1) {
#pragma unroll
            for (int t = 0; t < 32; ++t) glr[t] = PROJ[(t0 + t) * 1536 + 1024 + ch]; }
        LDS_WAIT(); CBAR();
#pragma unroll
        for (int t = 0; t < 32; ++t) {
            const float ra = __builtin_amdgcn_rcpf(1.0f + __builtin_amdgcn_exp2f(fmaf(GA[t * 68 + lane], -L2E, ba)));
            const float ri = __builtin_amdgcn_rcpf(1.0f + __builtin_amdgcn_exp2f(fmaf(GI[t * 68 + lane], -L2E, bi)));
            const float av = __builtin_amdgcn_exp2f(ra * lsl8);
            const float bv = __builtin_amdgcn_sqrtf(fmaxf(fmaf(-av, av, 1.0f), 0.f)) * (ri * xf[t]);
            hst = fmaf(av, hst, bv);
            if (PASS == 0) aprod *= av;
            else YCAT[(t0 + t) * 1024 + 512 + ch] = (bf16)f2bf(hst * gelu_tanh(bf2f(glr[t])));
        }
        LDS_WAIT(); CBAR();
    }
    if (PASS == 0) { CA[ci * 64 + lane] = aprod; CH[ci * 64 + lane] = hst; }
}
__device__ __forceinline__ void mixers_a(const Frame& F, const Args& a) {
    PSTART(28);
    if (PH(3)) for (int u = F.vcu; u < 256; u += F.G) lru_chunk<0>(F, a, u >> 5, (u >> 2) & 7, u & 3);
    CBAR(); __syncthreads(); CBAR();
    PEND(28); PSTART(29);
    if (PH(2)) for (int u = F.vcu; u < 256; u += F.G) s5_unit(F, a, u >> 5, u & 31);
    if (F.G != 256) { for (int i = F.gw; i < CV_STEPS; i += F.ngw) { f32x4 x[4]; cv_issue(a, 0, i, F.lane, x); cv_finish(a, 0, i, F.lane, x); } }
    PEND(29);
}
__device__ __forceinline__ void mixers_b(const Frame& F, const Args& a) {
    PSTART(30);
    if (PH(18)) for (int u = F.vcu; u < 256; u += F.G) lru_chunk<1>(F, a, u >> 5, (u >> 2) & 7, u & 3);
    CBAR(); __syncthreads(); CBAR();
    PEND(30);
}

__device__ __forceinline__ void router_phase(const Frame& F, const Args& a, int layer, const float* xin, const float* gain) {
    const int lane = F.lane, w = F.wave, r32 = lane & 31, hh = lane >> 5, tg = w & 1, kq = w >> 1;
    LAS float* LGP = (LAS float*)F.lds;
    LAS float* SSQ = (LAS float*)(F.lds + 102400);
    bf16* XN = (bf16*)(a.ws + WS_XN); const bf16* WrT = (const bf16*)(a.ws + WS_WR) + (size_t)layer * 96 * 1024;
    const float* bg = a.in[33] + layer * 8; const float* be = a.in[35] + layer * 64;
    unsigned* cnt = (unsigned*)(a.ws + WS_CTL) + CW_CNT + layer * 2048;
    int* TE = (int*)(a.ws + AR_TOK); float* TG = (float*)(a.ws + AR_TOK + 128 * 1024); int* TP = (int*)(a.ws + AR_TOK + 256 * 1024); int* SLOT = (int*)(a.ws + AR_SLOT);
    for (int u = F.vcu; u < NT / 64; u += F.G) {
        const size_t tok = (size_t)u * 64 + 32 * tg + r32;
        const float* xp = xin + tok * DM + 256 * kq + 8 * hh;
        float ss = 0.f;
#pragma unroll
        for (int s = 0; s < 16; ++s) { const f32x4 p = *(const f32x4*)(xp + 16 * s), q = *(const f32x4*)(xp + 16 * s + 4); ss += (p.x * p.x + p.y * p.y) + (p.z * p.z + p.w * p.w) + (q.x * q.x + q.y * q.y) + (q.z * q.z + q.w * q.w); }
        ss += __shfl_xor(ss, 32);
        if (hh == 0) SSQ[(tg * 4 + kq) * 32 + r32] = ss;
        LDS_WAIT(); __syncthreads();
        const float rs = rsqrtf(((SSQ[(tg * 4 + 0) * 32 + r32] + SSQ[(tg * 4 + 1) * 32 + r32]) + (SSQ[(tg * 4 + 2) * 32 + r32] + SSQ[(tg * 4 + 3) * 32 + r32])) * (1.f / DM) + RMS_EPS);
        f32x16 acc[3] = {};
        const float* gp = gain + 256 * kq + 8 * hh; const bf16* wp = WrT + (size_t)r32 * DM + 256 * kq + 8 * hh; bf16* xo = XN + tok * DM + 256 * kq + 8 * hh;
#pragma unroll
        for (int s = 0; s < 16; ++s) {
            const f32x4 g0 = *(const f32x4*)(gp + 16 * s), g1 = *(const f32x4*)(gp + 16 * s + 4); const f32x4 p = *(const f32x4*)(xp + 16 * s), q = *(const f32x4*)(xp + 16 * s + 4);
            v4u hv; hv.x = pk2(p.x * rs * g0.x, p.y * rs * g0.y); hv.y = pk2(p.z * rs * g0.z, p.w * rs * g0.w); hv.z = pk2(q.x * rs * g1.x, q.y * rs * g1.y); hv.w = pk2(q.z * rs * g1.z, q.w * rs * g1.w);
            *(v4u*)(xo + 16 * s) = hv;
            const bf16x8 xb = __builtin_bit_cast(bf16x8, hv);
#pragma unroll
            for (int blk = 0; blk < 3; ++blk) { const bf16x8 wa = *(const bf16x8*)(wp + (size_t)blk * 32 * DM + 16 * s); acc[blk] = __builtin_amdgcn_mfma_f32_32x32x16_bf16(wa, xb, acc[blk], 0, 0, 0); }
            if ((s & 3) == 3) CBAR();
        }
        LAS float* lg = LGP + ((kq * 2 + tg) * 32 + r32) * 100;
#pragma unroll
        for (int blk = 0; blk < 3; ++blk)
#pragma unroll
            for (int q = 0; q < 4; ++q) *(LAS f32x4*)(lg + 32 * blk + 8 * q + 4 * hh) = (f32x4){acc[blk][4 * q], acc[blk][4 * q + 1], acc[blk][4 * q + 2], acc[blk][4 * q + 3]};
        LDS_WAIT(); __syncthreads();
        if (w < 2 && lane < 32) {
            const LAS float* r0 = LGP + ((0 * 2 + w) * 32 + lane) * 100; const LAS float* r1 = r0 + 2 * 32 * 100; const LAS float* r2 = r1 + 2 * 32 * 100; const LAS float* r3 = r2 + 2 * 32 * 100;
            float gl[8]; float gmax = -3.0e38f; int gsel = 0;
#pragma unroll
            for (int i = 0; i < 8; ++i) { gl[i] = ((r0[i] + r1[i]) + (r2[i] + r3[i])) + bg[i]; if (gl[i] > gmax) { gmax = gl[i]; gsel = i; } }
            float gs = 0.f;
#pragma unroll
            for (int i = 0; i < 8; ++i) gs += __expf(gl[i] - gmax);
            const float pg = 1.0f / gs;
            float v1 = -3.0e38f, v2 = -3.0e38f; int i1 = 0, i2 = 0;
#pragma unroll
            for (int i = 0; i < 8; ++i) { const int c = 8 + gsel * 8 + i; const float v = ((r0[c] + r1[c]) + (r2[c] + r3[c])) + be[gsel * 8 + i];
                if (v > v1) { v2 = v1; i2 = i1; v1 = v; i1 = i; } else if (v > v2) { v2 = v; i2 = i; } }
            const float e2 = __expf(v2 - v1), inv = 1.0f / (1.0f + e2);
            const int ea = gsel * 8 + i1, eb = gsel * 8 + i2;
            const int t = u * 64 + 32 * w + lane;
            const unsigned pa = atomicAdd(cnt + ea * 16, 1u), pb = atomicAdd(cnt + eb * 16, 1u);
            SLOT[(size_t)ea * SLOT_CAP + pa] = t; SLOT[(size_t)eb * SLOT_CAP + pb] = t;
            TE[2 * t] = ea; TE[2 * t + 1] = eb; TG[2 * t] = pg * inv; TG[2 * t + 1] = pg * e2 * inv; TP[2 * t] = (int)pa; TP[2 * t + 1] = (int)pb;
        }
        __syncthreads();
    }
}
__device__ __forceinline__ void moe_tables(const Frame& F, const Args& a, int layer) {
    LAS int* PADS = (LAS int*)(F.lds + TAB_OFF); LAS int* TILE_E = PADS + 64; LAS int* NRT = TILE_E + MAX_RT; LAS int* CNT = (LAS int*)(F.lds + TAB_OFF + 1088);
    unsigned* cnt = (unsigned*)(a.ws + WS_CTL) + CW_CNT + layer * 2048;
    if (F.wave == 0) {
        const int e = F.lane; const int c = (int)__hip_atomic_load(cnt + e * 16, RLX_AGENT); const int nt = (c + 255) >> 8;
        int incl = nt;
#pragma unroll
        for (int o = 1; o < 64; o <<= 1) { const int v = __shfl_up(incl, o); if (e >= o) incl += v; }
        const int start = incl - nt;
        PADS[e] = start * 256; CNT[e] = c;
        for (int j = 0; j < nt; ++j) TILE_E[start + j] = e;
        if (e == 63) NRT[0] = incl;
    }
    LDS_WAIT(); __syncthreads();
}
template <bool NORM>
__device__ __forceinline__ void combine_phase(const Frame& F, const Args& a, const float* xin, float* xout, const float* gain, bf16* XN) {
    const bf16* YD = (const bf16*)(a.ws + AR_YDISP); const float* TG = (const float*)(a.ws + AR_TOK + 128 * 1024); const int* TE = (const int*)(a.ws + AR_TOK); const int* TP = (const int*)(a.ws + AR_TOK + 256 * 1024);
    const LAS int* PADS = (const LAS int*)(F.lds + TAB_OFF);
    f32x4 g[4];
    if (NORM) {
#pragma unroll
        for (int j = 0; j < 4; ++j) g[j] = *((const f32x4*)gain + F.lane + 64 * j); }
    for (int tb = F.gw * 8; tb < NT; tb += F.ngw * 8) {
        int d0l = 0, d1l = 0; float g0l = 0.f, g1l = 0.f;
        if (F.lane < 8) { const int t = tb + F.lane; const int e0 = TE[2 * t], e1 = TE[2 * t + 1], p0 = TP[2 * t], p1 = TP[2 * t + 1]; g0l = TG[2 * t]; g1l = TG[2 * t + 1]; d0l = PADS[e0] + p0; d1l = PADS[e1] + p1; }
#pragma unroll 1
        for (int i = 0; i < 8; i += 2) {
            f32x4 v[2][4];
#pragma unroll
            for (int u = 0; u < 2; ++u) {
                const int t = tb + i + u; const int d0 = __shfl(d0l, i + u), d1 = __shfl(d1l, i + u); const float g0 = __shfl(g0l, i + u), g1 = __shfl(g1l, i + u);
                const f32x4* xr = (const f32x4*)(xin + (size_t)t * DM) + F.lane; const v2u* y0 = (const v2u*)(YD + (size_t)d0 * DM) + F.lane; const v2u* y1 = (const v2u*)(YD + (size_t)d1 * DM) + F.lane;
#pragma unroll
                for (int j = 0; j < 4; ++j) { const f32x4 x = xr[64 * j]; const v2u a0 = y0[64 * j], a1 = y1[64 * j];
                    v[u][j].x = x.x + g0 * bflo(a0.x) + g1 * bflo(a1.x); v[u][j].y = x.y + g0 * bfhi(a0.x) + g1 * bfhi(a1.x);
                    v[u][j].z = x.z + g0 * bflo(a0.y) + g1 * bflo(a1.y); v[u][j].w = x.w + g0 * bfhi(a0.y) + g1 * bfhi(a1.y); }
            }
#pragma unroll
            for (int u = 0; u < 2; ++u) { const int t = tb + i + u;
                f32x4* xo = (f32x4*)(xout + (size_t)t * DM) + F.lane;
#pragma unroll
                for (int j = 0; j < 4; ++j) xo[64 * j] = v[u][j];
                if (NORM) norm_row(v[u], g, XN + (size_t)t * DM, F.lane); }
        }
    }
}

__device__ const float INV_FREQ[32] = {
    1.0f, 0.7498942093324559f, 0.5623413251903491f, 0.4216965034285822f, 0.31622776601683794f, 0.23713737056616552f, 0.1778279410038923f, 0.1333521432163324f,
    0.1f, 0.07498942093324558f, 0.05623413251903491f, 0.04216965034285822f, 0.031622776601683794f, 0.023713737056616554f, 0.01778279410038923f, 0.01333521432163324f,
    0.01f, 0.007498942093324558f, 0.005623413251903491f, 0.004216965034285822f, 0.0031622776601683794f, 0.0023713737056616554f, 0.001778279410038923f, 0.001333521432163324f,
    0.001f, 0.0007498942093324559f, 0.0005623413251903491f, 0.0004216965034285822f, 0.00031622776601683794f, 0.00023713737056616554f, 0.0001778279410038923f, 0.0001333521432163324f };
__device__ __forceinline__ void mla_lora_norm_phase(const Frame& F, const Args& a) {
    const bf16* CQR = (const bf16*)(a.ws + AR_CQR); const bf16* CKVR = (const bf16*)(a.ws + AR_CKVR);
    bf16* CQ = (bf16*)(a.ws + AR_CQ); bf16* CKV = (bf16*)(a.ws + AR_CKV); float* COS = (float*)(a.ws + AR_COS); float* SIN = (float*)(a.ws + AR_SIN);
    const int lane = F.lane;
    const bool isq = lane < 48;
    const bool iskv = lane < 32;
    float gq[8], gk[8];
#pragma unroll
    for (int j = 0; j < 8; ++j) { gq[j] = isq ? a.in[24][lane * 8 + j] : 0.f; gk[j] = iskv ? a.in[25][lane * 8 + j] : 0.f; }
    for (int t0 = F.gw * 2; t0 < NT; t0 += F.ngw * 2) {
        v4u rq[2], rk[2];
#pragma unroll
        for (int u = 0; u < 2; ++u) { const size_t t = t0 + u;
            rq[u] = isq ? *(const v4u*)(CQR + t * 384 + lane * 8) : (v4u){0u, 0u, 0u, 0u};
            rk[u] = iskv ? *(const v4u*)(CKVR + t * 256 + lane * 8) : (v4u){0u, 0u, 0u, 0u}; }
#pragma unroll
        for (int u = 0; u < 2; ++u) { const size_t t = t0 + u;
            float q[8] = {bflo(rq[u].x), bfhi(rq[u].x), bflo(rq[u].y), bfhi(rq[u].y), bflo(rq[u].z), bfhi(rq[u].z), bflo(rq[u].w), bfhi(rq[u].w)};
            float k[8] = {bflo(rk[u].x), bfhi(rk[u].x), bflo(rk[u].y), bfhi(rk[u].y), bflo(rk[u].z), bfhi(rk[u].z), bflo(rk[u].w), bfhi(rk[u].w)};
            float sq = 0.f, sk = 0.f;
#pragma unroll
            for (int j = 0; j < 8; ++j) { sq += q[j] * q[j]; sk += k[j] * k[j]; }
            const float nq = rsqrtf(wave_sum(sq) * (1.f / 384.f) + RMS_EPS), nk = rsqrtf(wave_sum(sk) * (1.f / 256.f) + RMS_EPS);
            if (isq) { v4u o; o.x = pk2(q[0] * nq * gq[0], q[1] * nq * gq[1]); o.y = pk2(q[2] * nq * gq[2], q[3] * nq * gq[3]); o.z = pk2(q[4] * nq * gq[4], q[5] * nq * gq[5]); o.w = pk2(q[6] * nq * gq[6], q[7] * nq * gq[7]);
                *(v4u*)(CQ + t * 384 + lane * 8) = o; }
            if (iskv) { v4u o; o.x = pk2(k[0] * nk * gk[0], k[1] * nk * gk[1]); o.y = pk2(k[2] * nk * gk[2], k[3] * nk * gk[3]); o.z = pk2(k[4] * nk * gk[4], k[5] * nk * gk[5]); o.w = pk2(k[6] * nk * gk[6], k[7] * nk * gk[7]);
                *(v4u*)(CKV + t * 256 + lane * 8) = o;
                const float ang = (float)a.pos[t] * INV_FREQ[lane];
                const double tw = 6.283185307179586476925286766559; const double ad = (double)ang; const double nn = __builtin_rint(ad / tw); const float rr = (float)(ad - nn * tw);
                COS[t * 32 + lane] = cosf(rr); SIN[t * 32 + lane] = sinf(rr); }
        }
    }
}
__device__ __forceinline__ void qk_row(const v4u r0, const v4u r1, const v4u r2, const float (&g0)[8], const float (&g1)[8], const float (&g2)[8], const float (&cs)[8], const float (&sn)[8], float sgn, float scale, bf16* dst, int sub) {
    float x0[8] = {bflo(r0.x), bfhi(r0.x), bflo(r0.y), bfhi(r0.y), bflo(r0.z), bfhi(r0.z), bflo(r0.w), bfhi(r0.w)};
    float x1[8] = {bflo(r1.x), bfhi(r1.x), bflo(r1.y), bfhi(r1.y), bflo(r1.z), bfhi(r1.z), bflo(r1.w), bfhi(r1.w)};
    float x2[8] = {bflo(r2.x), bfhi(r2.x), bflo(r2.y), bfhi(r2.y), bflo(r2.z), bfhi(r2.z), bflo(r2.w), bfhi(r2.w)};
    float ss = 0.f;
#pragma unroll
    for (int j = 0; j < 8; ++j) ss += x0[j] * x0[j] + x1[j] * x1[j] + x2[j] * x2[j];
    ss += __shfl_xor(ss, 1); ss += __shfl_xor(ss, 2); ss += __shfl_xor(ss, 4);
    const float rk = rsqrtf(ss * (1.f / 192.f) + RMS_EPS);
    float y2[8];
#pragma unroll
    for (int j = 0; j < 8; ++j) { x0[j] *= rk * g0[j]; x1[j] *= rk * g1[j]; x2[j] *= rk * g2[j]; }
#pragma unroll
    for (int j = 0; j < 8; ++j) { const float pr = __shfl_xor(x2[j], 4); y2[j] = (x2[j] * cs[j] + sgn * pr * sn[j]) * scale; }
    v4u o; o.x = pk2(x0[0] * scale, x0[1] * scale); o.y = pk2(x0[2] * scale, x0[3] * scale); o.z = pk2(x0[4] * scale, x0[5] * scale); o.w = pk2(x0[6] * scale, x0[7] * scale); *(v4u*)(dst + 8 * sub) = o;
    o.x = pk2(x1[0] * scale, x1[1] * scale); o.y = pk2(x1[2] * scale, x1[3] * scale); o.z = pk2(x1[4] * scale, x1[5] * scale); o.w = pk2(x1[6] * scale, x1[7] * scale); *(v4u*)(dst + 64 + 8 * sub) = o;
    o.x = pk2(y2[0], y2[1]); o.y = pk2(y2[2], y2[3]); o.z = pk2(y2[4], y2[5]); o.w = pk2(y2[6], y2[7]); *(v4u*)(dst + 128 + 8 * sub) = o;
}
__device__ __forceinline__ void mla_qk_phase(const Frame& F, const Args& a) {
    const bf16* QRAW = (const bf16*)(a.ws + AR_QRAW); const bf16* KNRAW = (const bf16*)(a.ws + AR_KNRAW); const bf16* KRR = (const bf16*)(a.ws + AR_KRR);
    bf16* QF = (bf16*)(a.ws + AR_QF); bf16* KF = (bf16*)(a.ws + AR_KF); const float* COS = (const float*)(a.ws + AR_COS); const float* SIN = (const float*)(a.ws + AR_SIN);
    const int lane = F.lane, h = lane >> 3, sub = lane & 7;
    float kg0[8], kg1[8], kg2[8], qg0[8], qg1[8], qg2[8];
#pragma unroll
    for (int j = 0; j < 8; ++j) { kg0[j] = a.in[29][8 * sub + j]; kg1[j] = a.in[29][64 + 8 * sub + j]; kg2[j] = a.in[29][128 + 8 * sub + j];
                                  qg0[j] = a.in[28][8 * sub + j]; qg1[j] = a.in[28][64 + 8 * sub + j]; qg2[j] = a.in[28][128 + 8 * sub + j]; }
    const float sgn = (sub < 4) ? -1.f : 1.f; const int ci = (8 * sub) & 31;
    const float QS = 1.4426950408889634f * 0.07216878364870322f;
    for (int t = F.gw; t < NT; t += F.ngw) {
        const int b = t >> 11, l = t & 2047;
        const v4u k0 = *(const v4u*)(KNRAW + (size_t)t * 1024 + h * 128 + 8 * sub), k1 = *(const v4u*)(KNRAW + (size_t)t * 1024 + h * 128 + 64 + 8 * sub), k2 = *(const v4u*)(KRR + (size_t)t * 64 + 8 * sub);
        const v4u q0 = *(const v4u*)(QRAW + (size_t)t * 1536 + h * 192 + 8 * sub), q1 = *(const v4u*)(QRAW + (size_t)t * 1536 + h * 192 + 64 + 8 * sub), q2 = *(const v4u*)(QRAW + (size_t)t * 1536 + h * 192 + 128 + 8 * sub);
        const f32x4 c0 = *(const f32x4*)(COS + (size_t)t * 32 + ci), c1 = *(const f32x4*)(COS + (size_t)t * 32 + ci + 4), s0 = *(const f32x4*)(SIN + (size_t)t * 32 + ci), s1 = *(const f32x4*)(SIN + (size_t)t * 32 + ci + 4);
        const float cs[8] = {c0.x, c0.y, c0.z, c0.w, c1.x, c1.y, c1.z, c1.w}; const float sn[8] = {s0.x, s0.y, s0.z, s0.w, s1.x, s1.y, s1.z, s1.w};
        const size_t orow = ((size_t)(b * 8 + h) * SL + l) * 192;
        qk_row(k0, k1, k2, kg0, kg1, kg2, cs, sn, sgn, 1.0f, KF + orow, sub);
        qk_row(q0, q1, q2, qg0, qg1, qg2, cs, sn, sgn, QS, QF + orow, sub);
    }
}

constexpr int AT_KB = 64 * 400, AT_VB = 128 * 144 + 256, AT_VOFF = 2 * AT_KB;
__device__ __forceinline__ void attn_block(const Frame& F, const Args& a, int b, int h, int qb, int& cvk) {
    const int tid = F.tid, lane = F.lane, w = F.wave, r32 = lane & 31, hh = lane >> 5;
    const bf16* KF = (const bf16*)(a.ws + AR_KF); const bf16* VT = (const bf16*)(a.ws + AR_VT); bf16* O = (bf16*)(a.ws + AR_O);
    LAS unsigned char* lds = F.lds;
    const int q0 = qb * 256, qrow0 = q0 + 32 * w, nt = 4 * (qb + 1);
    const bf16* Kg = KF + (size_t)(b * 8 + h) * SL * 192;
    const bf16* Vg = VT + (size_t)(h * 128) * NT + (size_t)b * SL;
    asm volatile("" : "+s"(Kg), "+s"(Vg));
    bf16x8 qf[12];
    { const bf16* qp = (const bf16*)(a.ws + AR_QF) + ((size_t)(b * 8 + h) * SL + qrow0 + r32) * 192 + 8 * hh;
#pragma unroll
      for (int s = 0; s < 12; ++s) qf[s] = *(const bf16x8*)(qp + 16 * s); }
    CBAR(); __builtin_amdgcn_sched_barrier(0);
    f32x16 o[4] = {};
    float mrun = -1e30f, lrun = 0.f;
    unsigned koff[4], voff[3];
#pragma unroll
    for (int i = 0; i < 4; ++i) { const int P = (w + 8 * i) * 64 + lane, row = P / 25, col = P - row * 25; koff[i] = (col < 24 && row < 64) ? (unsigned)(row * 384 + col * 16) : 0u; }
#pragma unroll
    for (int i = 0; i < 3; ++i) { const int P = (w + 8 * i) * 64 + lane, row = P / 9, col = P - row * 9; voff[i] = (col < 8 && row < 128) ? (unsigned)(row * (NT * 2) + col * 16) : 0u; }
#define AT_LOAD(j, bf) do { const char* kt = (const char*)Kg + (size_t)(j) * 64 * 384; const char* vt = (const char*)Vg + (size_t)(j) * 128; \
        _Pragma("unroll") for (int i = 0; i < 4; ++i) if (w + 8 * i < 25) __builtin_amdgcn_global_load_lds((const unsigned*)(kt + koff[i]), (LAS unsigned*)(lds + (bf) * AT_KB + (w + 8 * i) * 1024), 16, 0, 0); \
        _Pragma("unroll") for (int i = 0; i < 3; ++i) if (w + 8 * i < 18) __builtin_amdgcn_global_load_lds((const unsigned*)(vt + voff[i]), (LAS unsigned*)(lds + AT_VOFF + (bf) * AT_VB + (w + 8 * i) * 1024), 16, 0, 0); } while (0)
    CvPipe cvp; cvp.pending = false; cvp.dst = nullptr; cvp.ldk = 0;
    AT_LOAD(0, 0);
    for (int j = 0; j < nt; ++j) {
        const int bf = j & 1;
        VM_WAIT(); __syncthreads(); CBAR();
        if (j + 1 < nt) AT_LOAD(j + 1, bf ^ 1);
        { const bool more = cvk < CV_PER_WAVE; cv_step(a, 1, F.gw + cvk * F.ngw, more, lane, cvp); if (more) ++cvk; }
        if (j * 64 <= qrow0 + 31) {
            f32x16 p0 = {}, p1 = {};
            const LAS unsigned char* kb = lds + bf * AT_KB + r32 * 400 + hh * 16;
#pragma unroll
            for (int s = 0; s < 12; ++s) {
                const bf16x8 a0 = *(const LAS bf16x8*)(kb + 32 * s), a1 = *(const LAS bf16x8*)(kb + 32 * 400 + 32 * s);
                p0 = __builtin_amdgcn_mfma_f32_32x32x16_bf16(a0, qf[s], p0, 0, 0, 0);
                p1 = __builtin_amdgcn_mfma_f32_32x32x16_bf16(a1, qf[s], p1, 0, 0, 0);
            }
            if (j * 64 + 63 > qrow0) {
                const int qpos = qrow0 + r32, kbase = j * 64 + 4 * hh;
#pragma unroll
                for (int r = 0; r < 16; ++r) { const int kk = kbase + (r & 3) + 8 * (r >> 2);
                    if (kk > qpos) p0[r] = -__builtin_inff();
                    if (kk + 32 > qpos) p1[r] = -__builtin_inff(); }
            }
            float mx = p0[0];
#pragma unroll
            for (int r = 1; r < 16; ++r) mx = fmaxf(mx, p0[r]);
#pragma unroll
            for (int r = 0; r < 16; ++r) mx = fmaxf(mx, p1[r]);
            mx = fmaxf(mx, __shfl_xor(mx, 32));
            const float mn = fmaxf(mrun, mx), alpha = __builtin_amdgcn_exp2f(mrun - mn); mrun = mn;
            float ps = 0.f;
#pragma unroll
            for (int r = 0; r < 16; ++r) { p0[r] = __builtin_amdgcn_exp2f(p0[r] - mn); ps += p0[r]; }
#pragma unroll
            for (int r = 0; r < 16; ++r) { p1[r] = __builtin_amdgcn_exp2f(p1[r] - mn); ps += p1[r]; }
            ps += __shfl_xor(ps, 32);
            lrun = lrun * alpha + ps;
#pragma unroll
            for (int d = 0; d < 4; ++d)
#pragma unroll
                for (int r = 0; r < 16; ++r) o[d][r] *= alpha;
            bf16x8 pb[4];
            { v4u x;
              x.x = pg8::cvt_pk_bf16(p0[0], p0[1]); x.y = pg8::cvt_pk_bf16(p0[2], p0[3]); x.z = pg8::cvt_pk_bf16(p0[4], p0[5]); x.w = pg8::cvt_pk_bf16(p0[6], p0[7]); pb[0] = __builtin_bit_cast(bf16x8, x);
              x.x = pg8::cvt_pk_bf16(p0[8], p0[9]); x.y = pg8::cvt_pk_bf16(p0[10], p0[11]); x.z = pg8::cvt_pk_bf16(p0[12], p0[13]); x.w = pg8::cvt_pk_bf16(p0[14], p0[15]); pb[1] = __builtin_bit_cast(bf16x8, x);
              x.x = pg8::cvt_pk_bf16(p1[0], p1[1]); x.y = pg8::cvt_pk_bf16(p1[2], p1[3]); x.z = pg8::cvt_pk_bf16(p1[4], p1[5]); x.w = pg8::cvt_pk_bf16(p1[6], p1[7]); pb[2] = __builtin_bit_cast(bf16x8, x);
              x.x = pg8::cvt_pk_bf16(p1[8], p1[9]); x.y = pg8::cvt_pk_bf16(p1[10], p1[11]); x.z = pg8::cvt_pk_bf16(p1[12], p1[13]); x.w = pg8::cvt_pk_bf16(p1[14], p1[15]); pb[3] = __builtin_bit_cast(bf16x8, x); }
            const LAS unsigned char* vb = lds + AT_VOFF + bf * AT_VB + r32 * 144 + hh * 8;
#pragma unroll
            for (int d = 0; d < 4; ++d)
#pragma unroll
                for (int s = 0; s < 4; ++s) {
                    const LAS unsigned char* vp = vb + d * 32 * 144 + s * 32;
                    const v2u lo = *(const LAS v2u*)vp, hi = *(const LAS v2u*)(vp + 16);
                    const v4u av = {lo.x, lo.y, hi.x, hi.y};
                    o[d] = __builtin_amdgcn_mfma_f32_32x32x16_bf16(__builtin_bit_cast(bf16x8, av), pb[s], o[d], 0, 0, 0);
                }
        }
    }
    cv_step(a, 1, 0, false, lane, cvp);
#undef AT_LOAD
    const float inv = 1.0f / lrun;
    bf16* opu = O + ((size_t)b * SL + qrow0) * 1024 + h * 128; const unsigned oo = (unsigned)(r32 * 1024 + 4 * hh);
    asm volatile("" : "+s"(opu));
#pragma unroll
    for (int d = 0; d < 4; ++d)
#pragma unroll
        for (int q = 0; q < 4; ++q) { v2u wv; wv.x = pk2(o[d][4 * q] * inv, o[d][4 * q + 1] * inv); wv.y = pk2(o[d][4 * q + 2] * inv, o[d][4 * q + 3] * inv);
            *(v2u*)(opu + (oo + 32 * d + 8 * q)) = wv; }
    __syncthreads();
}
__device__ __forceinline__ void attn_phase(const Frame& F, const Args& a) {
    int cvk = 0;
    for (int u = F.vcu; u < 256; u += F.G) {
        const int bh = u >> 2, x = u & 3;
        attn_block(F, a, bh >> 3, bh & 7, 7 - x, cvk);
        attn_block(F, a, bh >> 3, bh & 7, x, cvk);
    }
    for (; cvk < CV_PER_WAVE; ++cvk) { f32x4 cvx[4]; const int cvi = F.gw + cvk * F.ngw; cv_issue(a, 1, cvi, F.lane, cvx); cv_finish(a, 1, cvi, F.lane, cvx); }
    if (F.G != 256) { for (int i = F.gw; i < CV_STEPS; i += F.ngw) { f32x4 x[4]; cv_issue(a, 1, i, F.lane, x); cv_finish(a, 1, i, F.lane, x); } }
}

__device__ __forceinline__ void copy_out(const Frame& F, const float* src, float* dst) {
    for (size_t i = (size_t)F.gw * 64 + F.lane; i < (size_t)NT * DM / 4; i += (size_t)F.ngw * 64) ((f32x4*)dst)[i] = ((const f32x4*)src)[i];
}
template <int LAYER>
__device__ __forceinline__ void moe_block(Frame& F, const Args& a, const XcdBarrier& bar) {
#define MB_BAR() do { xcd_barrier(bar); asm volatile("" : "+v"(F.tid)); F.tid &= 511; F.lane = F.tid & 63; } while (0)
    unsigned char* ws = a.ws; PG8_LAS unsigned char* ring = (PG8_LAS unsigned char*)F.lds;
    float* const OUT = a.out; float* const X2 = (float*)(ws + WS_X2); bf16* const XN = (bf16*)(ws + WS_XN);
    PSTART(20 + 4 * LAYER);
    if (PH(7)) router_phase(F, a, LAYER, OUT, a.in[31] + LAYER * 1024);
    MB_BAR();
    PEND(20 + 4 * LAYER); PSTART(21 + 4 * LAYER);
    moe_tables(F, a, LAYER);
    const PG8_LAS int* TAB = (const PG8_LAS int*)(F.lds + TAB_OFF);
    if (PH(9)) {
        pg8::GroupedOrder S{TAB + 64, TAB[64 + MAX_RT], 2, F.G, F.vcu, TAB, TAB + 272, (const int*)(ws + AR_SLOT), SLOT_CAP};
        pg8::Gemm g{XN, (const bf16*)(ws + WS_W13), MAX_RT * 256, 64 * 512, 1024};
        pg8::EpiSwiGlu E{(bf16*)(ws + AR_H)};
        pg8::gemm_phase<pg8::EpiSwiGlu, pg8::GroupedOrder, false, true>(ring, g, S, E, nullptr);
    }
    MB_BAR();
    PEND(21 + 4 * LAYER); PSTART(22 + 4 * LAYER);
    if (PH(10)) {
        pg8::GroupedOrder S{TAB + 64, TAB[64 + MAX_RT], 4, F.G, F.vcu, TAB, TAB + 272, (const int*)(ws + AR_SLOT), SLOT_CAP};
        int k2 = 256; asm volatile("" : "+s"(k2));
        pg8::Gemm g{(const bf16*)(ws + AR_H), (const bf16*)(ws + WS_W2), MAX_RT * 256, 64 * 1024, k2};
        pg8::EpiBf16N E{(bf16*)(ws + AR_YDISP), 1024, 4};
        pg8::gemm_phase<pg8::EpiBf16N, pg8::GroupedOrder>(ring, g, S, E, nullptr);
    }
    MB_BAR();
    PEND(22 + 4 * LAYER); PSTART(23 + 4 * LAYER);
    if (PH(17)) { if (LAYER == 0) combine_phase<true>(F, a, OUT, X2, a.in[22], XN); else combine_phase<false>(F, a, OUT, OUT, nullptr, nullptr); }
}
__global__ void __launch_bounds__(NWAVES * 64, 2) fwd_kernel(Args a) {
    extern __shared__ __attribute__((aligned(16))) unsigned char lds_raw[];
    Frame F;
    F.lds = (LAS unsigned char*)lds_raw;
    F.tid = threadIdx.x; F.lane = F.tid & 63; F.wave = __builtin_amdgcn_readfirstlane(F.tid >> 6);
    F.G = gridDim.x; { const int bx = blockIdx.x; F.vcu = (F.G % 8 == 0) ? (bx % 8) * (F.G / 8) + bx / 8 : bx; }
    F.gw = F.vcu * NWAVES + F.wave; F.ngw = F.G * NWAVES;
    volatile LAS unsigned* MISC = (volatile LAS unsigned*)(F.lds + MISC_OFF);
    for (int u = F.tid; u < (LDS_BYTES - TAB_OFF) / 4; u += NWAVES * 64) ((LAS unsigned*)(F.lds + TAB_OFF))[u] = 0u;
    __syncthreads();
    unsigned char* ws = a.ws;
    XcdBarrier bar = xcd_barrier_post((unsigned*)(ws + WS_CTL) + CW_BAR, MISC + 8);
#define RELAUNDER() do { asm volatile("" : "+v"(F.tid)); F.tid &= 511; F.lane = F.tid & 63; } while (0)
#define GRID_BAR() do { xcd_barrier(bar); RELAUNDER(); } while (0)
    PG8_LAS unsigned char* ring = (PG8_LAS unsigned char*)F.lds;
    const int G = F.G, bx = (int)blockIdx.x;
    float* const OUT = a.out; float* const X2 = (float*)(ws + WS_X2); bf16* const XN = (bf16*)(ws + WS_XN);

    PSTART(0);
    if (PH(0)) RUNREP(0, p0_prologue(F, a));
    for (int xb = 0; xb < XBARS; ++xb) xcd_barrier(bar);
    GRID_BAR();
    PEND(0); PSTART(1);
    if (PH(1)) {
        pg8::Gemm g{XN, (const bf16*)(ws + WS_WIN), NT, 1536, 1024}; pg8::StaticOrder S; S.init(NT, 1536, G, bx);
        pg8::EpiBf16N E{(bf16*)(ws + AR_PROJ), 1536, 1 << 20};
        pg8::gemm_phase<pg8::EpiBf16N, pg8::StaticOrder>(ring, g, S, E, nullptr);
    }
    GRID_BAR();
    PEND(1); PSTART(2);
    RUNREP(2, mixers_a(F, a));
    GRID_BAR();
    PEND(2); PSTART(3);
    RUNREP(3, mixers_b(F, a));
    if (PH(4)) {
        pg8::Gemm g{(const bf16*)(ws + AR_YAPRE), (const bf16*)(ws + WS_GLU), NT, 512, 512}; pg8::StaticOrder S; S.init(NT, 512, G, bx);
        pg8::EpiGlu E{(const bf16*)(ws + AR_YAPRE), 512, (bf16*)(ws + AR_YCAT), 1024, a.in[13]};
        pg8::gemm_phase<pg8::EpiGlu, pg8::StaticOrder>(ring, g, S, E, nullptr);
    }
    GRID_BAR();
    PEND(3); PSTART(5);
    if (PH(5)) {
        pg8::Gemm g{(const bf16*)(ws + AR_YCAT), (const bf16*)(ws + WS_WOUT), NT, 1024, 1024}; pg8::StaticOrder S; S.init(NT, 1024, G, bx);
        pg8::EpiResF32 E{a.in[0], OUT, 1024};
        pg8::gemm_phase<pg8::EpiResF32, pg8::StaticOrder>(ring, g, S, E, nullptr);
    }
    GRID_BAR();
    PEND(5);
    moe_block<0>(F, a, bar);
    GRID_BAR();
    PEND(23); PSTART(11);
    if (PH(11)) {
        pg8::Gemm g{XN, (const bf16*)(ws + WS_MIN), NT, 768, 1024}; pg8::StaticOrder S; S.init(NT, 768, G, bx);
        pg8::EpiMlaIn E{(bf16*)(ws + AR_CQR), (bf16*)(ws + AR_CKVR), (bf16*)(ws + AR_KRR)};
        pg8::gemm_phase<pg8::EpiMlaIn, pg8::StaticOrder>(ring, g, S, E, nullptr);
    }
    GRID_BAR();
    PEND(11); PSTART(12);
    if (PH(12)) RUNREP(12, mla_lora_norm_phase(F, a));
    GRID_BAR();
    PEND(12); PSTART(13);
    if (PH(13)) {
        { pg8::Gemm g{(const bf16*)(ws + AR_CQ), (const bf16*)(ws + WS_UQ), NT, 1536, 384}; pg8::StaticOrder S; S.init(NT, 1536, G, bx);
          pg8::EpiBf16N E{(bf16*)(ws + AR_QRAW), 1536, 1 << 20}; pg8::gemm_phase<pg8::EpiBf16N, pg8::StaticOrder>(ring, g, S, E, nullptr); }
        CBAR(); __syncthreads(); CBAR();
        { pg8::Gemm g{(const bf16*)(ws + AR_CKV), (const bf16*)(ws + WS_UK), NT, 1024, 256}; pg8::StaticOrder S; S.init(NT, 1024, G, bx);
          pg8::EpiBf16N E{(bf16*)(ws + AR_KNRAW), 1024, 1 << 20}; pg8::gemm_phase<pg8::EpiBf16N, pg8::StaticOrder>(ring, g, S, E, nullptr); }
        CBAR(); __syncthreads(); CBAR();
        { pg8::Gemm g{(const bf16*)(ws + WS_UV), (const bf16*)(ws + AR_CKV), 1024, NT, 256}; pg8::StaticOrder S; S.init(1024, NT, G, bx);
          pg8::EpiBf16N E{(bf16*)(ws + AR_VT), NT, 1 << 20}; pg8::gemm_phase<pg8::EpiBf16N, pg8::StaticOrder>(ring, g, S, E, nullptr); }
    }
    GRID_BAR();
    PEND(13); PSTART(14);
    if (PH(14)) RUNREP(14, mla_qk_phase(F, a));
    GRID_BAR();
    PEND(14); PSTART(15);
    if (PH(15)) RUNREP(15, attn_phase(F, a));
    GRID_BAR();
    PEND(15); PSTART(16);
    if (PH(16)) {
        pg8::Gemm g{(const bf16*)(ws + AR_O), (const bf16*)(ws + WS_WO), NT, 1024, 1024}; pg8::StaticOrder S; S.init(NT, 1024, G, bx);
        pg8::EpiResF32 E{X2, OUT, 1024};
        pg8::gemm_phase<pg8::EpiResF32, pg8::StaticOrder>(ring, g, S, E, nullptr);
    }
    GRID_BAR();
    PEND(16);
    moe_block<1>(F, a, bar);
    PEND(27);
    PFINAL();
}

extern "C" void kernel_launch(void* const* d_in, const int* in_sizes, int n_in, void* d_out, int out_size, void* d_ws, size_t ws_size, hipStream_t stream) {
    static int grid = 0;
    if (grid == 0) {
        if (n_in != 39 || out_size != NT * DM || ws_size < WS_END) { fprintf(stderr, "kernel_launch: unexpected shapes (n_in %d out %d ws %zu, need %zu)\n", n_in, out_size, ws_size, (size_t)WS_END); grid = -1; return; }
        int dev = 0, cus = 0, per_cu = 0;
        if (hipGetDevice(&dev) != hipSuccess || hipDeviceGetAttribute(&cus, hipDeviceAttributeMultiprocessorCount, dev) != hipSuccess) { grid = -1; return; }
        if (hipFuncSetAttribute((const void*)fwd_kernel, hipFuncAttributeMaxDynamicSharedMemorySize, LDS_BYTES) != hipSuccess) { fprintf(stderr, "kernel_launch: hipFuncSetAttribute failed\n"); grid = -1; return; }
        if (hipOccupancyMaxActiveBlocksPerMultiprocessor(&per_cu, (const void*)fwd_kernel, NWAVES * 64, LDS_BYTES) != hipSuccess || per_cu < 1) { fprintf(stderr, "kernel_launch: occupancy query says %d\n", per_cu); }
        (void)hipGetLastError();
        grid = cus;
    }
    if (grid < 0) return;
    (void)hipMemsetAsync((char*)d_ws + WS_CTL, 0, CTL_ZERO_BYTES, stream);
    Args a{};
    for (int i = 0; i < 39; ++i) a.in[i] = (const float*)d_in[i];
    a.pos = (const int*)d_in[1]; a.out = (float*)d_out; a.ws = (unsigned char*)d_ws;
    hipLaunchKernelGGL(fwd_kernel, dim3(grid), dim3(NWAVES * 64), LDS_BYTES, stream, a);
}
```
